# Optimizing an MI355X kernel written in HIP

```python
import jax, jax.numpy as jnp
from jax import lax
import numpy as np

D_MODEL = 2048
BATCH = 4
SEQ = 4096
DEPTH = 1

EPS = 1e-6
ROPE_THETA = 500000.0
GLA_HEADS = 4
GLA_DK = 128
GLA_DV = 256
GLA_LOWRANK = 16
GLA_TAU = 16.0
GLA_CHUNK = 64
NSA_HEADS = 16
NSA_GROUPS = 4
NSA_HPG = NSA_HEADS // NSA_GROUPS
NSA_DH = 128
ROPE_DIM = NSA_DH // 4
CMP_BLOCK = 32
CMP_STRIDE = 16
SLC_BLOCK = 64
SLC_TOPN = 16
WINDOW = 512
NSA_QCHUNK = 64
PEER_HEADS = 8
PEER_NKEYS = 128
PEER_EXPERTS = PEER_NKEYS * PEER_NKEYS
PEER_DKEY = 128
PEER_TOPK = 16
PEER_CHUNK = 128
NSA_Q_COLS = NSA_HEADS * NSA_DH
NSA_KV_COLS = NSA_GROUPS * NSA_DH
NSA_GATE_COLS = NSA_HEADS * 3
GLA_QK_COLS = GLA_HEADS * GLA_DK
GLA_V_COLS = GLA_HEADS * GLA_DV
MERGE_COLS = D_MODEL
IN_COLS = NSA_Q_COLS + 6 * NSA_KV_COLS + NSA_GATE_COLS + 2 * GLA_QK_COLS + 2 * GLA_V_COLS + GLA_LOWRANK + 2 * MERGE_COLS

kernel_name = "hybrid_gla_nsa_peer_block"


def rmsnorm(x, g):
    xf = x.astype(jnp.float32)
    y = xf * lax.rsqrt(jnp.mean(xf * xf, axis=-1, keepdims=True) + EPS)
    return (y * g.astype(jnp.float32)).astype(x.dtype)


def partial_rope(x, positions):
    half = ROPE_DIM // 2
    inv = jnp.power(ROPE_THETA, -(jnp.arange(0, ROPE_DIM, 2, dtype=jnp.float32) / ROPE_DIM))
    ang = positions.astype(jnp.float32)[..., None] * inv
    cos = jnp.cos(ang)[:, :, None, :]
    sin = jnp.sin(ang)[:, :, None, :]
    xr = x[..., :ROPE_DIM].astype(jnp.float32)
    x1, x2 = xr[..., :half], xr[..., half:]
    rot = jnp.concatenate([x1 * cos - x2 * sin, x2 * cos + x1 * sin], axis=-1).astype(x.dtype)
    return jnp.concatenate([rot, x[..., ROPE_DIM:]], axis=-1)


def masked_softmax(s, mask):
    s = jnp.where(mask, s, -jnp.inf)
    m = jnp.max(s, axis=-1, keepdims=True)
    m = jnp.where(jnp.isfinite(m), m, 0.0)
    p = jnp.where(mask, jnp.exp(s - m), 0.0)
    return p / jnp.maximum(jnp.sum(p, axis=-1, keepdims=True), 1e-30)


def gla_mixer(q, k, v, log_a, r, norm_g):
    B, S, H, _ = q.shape
    C = GLA_CHUNK
    nc = S // C

    def to_chunks(t):
        return t.astype(jnp.float32).reshape(B, nc, C, H, t.shape[-1]).transpose(1, 0, 3, 2, 4)

    qc = to_chunks(q * (GLA_DK ** -0.5))
    kc, vc, gc = to_chunks(k), to_chunks(v), to_chunks(log_a)
    causal = jnp.tril(jnp.ones((C, C), dtype=bool))

    def step(state, inp):
        qi, ki, vi, gi = inp
        b = jnp.cumsum(gi, axis=2)
        diff = b[:, :, :, None, :] - b[:, :, None, :, :]
        decay = jnp.exp(jnp.where(causal[:, :, None], diff, -jnp.inf))
        attn = jnp.einsum('bhtd,bhsd,bhtsd->bhts', qi, ki, decay)
        o = jnp.einsum('bhts,bhse->bhte', attn, vi) + jnp.einsum('bhtd,bhde->bhte', qi * jnp.exp(b), state)
        b_last = b[:, :, -1:, :]
        new_state = jnp.exp(b_last[:, :, 0, :])[..., None] * state + jnp.einsum('bhsd,bhse->bhde', ki * jnp.exp(b_last - b), vi)
        return new_state, o

    state0 = jnp.zeros((B, H, GLA_DK, GLA_DV), jnp.float32)
    _, o = lax.scan(step, state0, (qc, kc, vc, gc))
    o = o.transpose(1, 0, 3, 2, 4).reshape(B, S, H, GLA_DV)
    o = rmsnorm(o, norm_g).reshape(B, S, H * GLA_DV)
    return (o * jax.nn.silu(r.astype(jnp.float32))).astype(r.dtype)


def nsa_mixer(q, k_cmp, v_cmp, k_slc, v_slc, k_win, v_win, gates, pos_k, pos_v, k_w1, k_w2, v_w1, v_w2):
    B, S, H, dh = q.shape
    G = NSA_GROUPS
    dtype = q.dtype
    scale = dh ** -0.5
    qg = q.reshape(B, S, G, NSA_HPG, dh).transpose(0, 2, 3, 1, 4)

    def grp(t):
        return t.transpose(0, 2, 1, 3)

    n_cmp = (S - CMP_BLOCK) // CMP_STRIDE + 1
    blk_idx = jnp.arange(n_cmp)[:, None] * CMP_STRIDE + jnp.arange(CMP_BLOCK)[None, :]

    def compress(t, pos, w1, w2):
        blocks = t[:, :, blk_idx] + pos
        hid = jax.nn.gelu(blocks.reshape(B, G, n_cmp, CMP_BLOCK * dh) @ w1)
        return hid @ w2

    kc = compress(grp(k_cmp), pos_k, k_w1, k_w2)
    vc = compress(grp(v_cmp), pos_v, v_w1, v_w2)
    t_pos = jnp.arange(S)
    cmp_end = jnp.arange(n_cmp) * CMP_STRIDE + CMP_BLOCK - 1
    cmask = cmp_end[None, :] <= t_pos[:, None]
    s_cmp = jnp.einsum('bghsd,bgnd->bghsn', qg, kc).astype(jnp.float32) * scale
    p_cmp = masked_softmax(s_cmp, cmask)
    o_cmp = jnp.einsum('bghsn,bgnd->bghsd', p_cmp.astype(dtype), vc)

    n_slc = S // SLC_BLOCK
    top_n = min(SLC_TOPN, n_slc)
    ratio = SLC_BLOCK // CMP_STRIDE
    nrep = CMP_BLOCK // CMP_STRIDE
    p_grp = jnp.sum(p_cmp, axis=2)
    padded = jnp.pad(p_grp, ((0, 0), (0, 0), (0, 0), (nrep - 1, nrep - 1)))
    imp = jnp.zeros(p_grp.shape[:-1] + (n_slc,), jnp.float32)
    for m in range(ratio):
        for n in range(nrep):
            start = m - n + nrep - 1
            imp = imp + padded[..., start::ratio][..., :n_slc]
    blk_t = t_pos // SLC_BLOCK
    j = jnp.arange(n_slc)
    forced = (j[None, :] == 0) | (j[None, :] == blk_t[:, None]) | (j[None, :] == blk_t[:, None] - 1)
    future = j[None, :] > blk_t[:, None]
    imp = jnp.where(forced, 1e9, jnp.where(future, -1e9, imp))
    _, sel = lax.top_k(imp, top_n)

    k_blocks = grp(k_slc).reshape(B, G, n_slc, SLC_BLOCK, dh)
    v_blocks = grp(v_slc).reshape(B, G, n_slc, SLC_BLOCK, dh)
    kw_pad = jnp.pad(grp(k_win), ((0, 0), (0, 0), (WINDOW, 0), (0, 0)))
    vw_pad = jnp.pad(grp(v_win), ((0, 0), (0, 0), (WINDOW, 0), (0, 0)))
    QC = NSA_QCHUNK
    nq = S // QC
    q_chunks = qg.reshape(B, G, NSA_HPG, nq, QC, dh).transpose(3, 0, 1, 2, 4, 5)
    sel_chunks = sel.reshape(B, G, nq, QC, top_n).transpose(2, 0, 1, 3, 4)
    starts = jnp.arange(nq, dtype=jnp.int32) * QC
    bi = jnp.arange(B)[:, None, None, None]
    gi = jnp.arange(G)[None, :, None, None]

    def sweep(args):
        qc, sc, c0 = args
        tq = c0 + jnp.arange(QC)
        ks = k_blocks[bi, gi, sc].reshape(B, G, QC, top_n * SLC_BLOCK, dh)
        vs = v_blocks[bi, gi, sc].reshape(B, G, QC, top_n * SLC_BLOCK, dh)
        kpos = (sc[..., None] * SLC_BLOCK + jnp.arange(SLC_BLOCK)).reshape(B, G, QC, top_n * SLC_BLOCK)
        smask = (kpos <= tq[None, None, :, None])[:, :, None]
        s = jnp.einsum('bghqd,bgqkd->bghqk', qc, ks).astype(jnp.float32) * scale
        o_s = jnp.einsum('bghqk,bgqkd->bghqd', masked_softmax(s, smask).astype(dtype), vs)
        kw = lax.dynamic_slice_in_dim(kw_pad, c0, QC + WINDOW, axis=2)
        vw = lax.dynamic_slice_in_dim(vw_pad, c0, QC + WINDOW, axis=2)
        ppos = c0 + jnp.arange(QC + WINDOW)
        wmask = (ppos[None, :] > tq[:, None]) & (ppos[None, :] <= tq[:, None] + WINDOW) & (ppos[None, :] >= WINDOW)
        s = jnp.einsum('bghqd,bgkd->bghqk', qc, kw).astype(jnp.float32) * scale
        o_w = jnp.einsum('bghqk,bgkd->bghqd', masked_softmax(s, wmask).astype(dtype), vw)
        return o_s, o_w

    o_slc, o_win = lax.map(sweep, (q_chunks, sel_chunks, starts))
    o_slc = o_slc.transpose(1, 2, 3, 0, 4, 5).reshape(B, G, NSA_HPG, S, dh)
    o_win = o_win.transpose(1, 2, 3, 0, 4, 5).reshape(B, G, NSA_HPG, S, dh)

    g = jax.nn.sigmoid(gates.astype(jnp.float32)).reshape(B, S, G, NSA_HPG, 3).transpose(0, 2, 3, 1, 4)
    o = g[..., 0:1] * o_cmp + g[..., 1:2] * o_slc + g[..., 2:3] * o_win
    return o.transpose(0, 3, 1, 2, 4).reshape(B, S, H * dh).astype(dtype)


def peer(xn, w_q, sub_k1, sub_k2, u_tab, v_tab):
    B, S, D = xn.shape
    T = B * S
    xt = xn.reshape(T, D)
    qp = (xt @ w_q).reshape(T, PEER_HEADS, PEER_DKEY)
    half = PEER_DKEY // 2
    s1 = jnp.einsum('thd,hnd->thn', qp[..., :half], sub_k1).astype(jnp.float32)
    s2 = jnp.einsum('thd,hnd->thn', qp[..., half:], sub_k2).astype(jnp.float32)
    v1, i1 = lax.top_k(s1, PEER_TOPK)
    v2, i2 = lax.top_k(s2, PEER_TOPK)
    cand = (v1[..., :, None] + v2[..., None, :]).reshape(T, PEER_HEADS, PEER_TOPK * PEER_TOPK)
    vals, flat = lax.top_k(cand, PEER_TOPK)
    e1 = jnp.take_along_axis(i1, flat // PEER_TOPK, axis=-1)
    e2 = jnp.take_along_axis(i2, flat % PEER_TOPK, axis=-1)
    experts = e1 * PEER_NKEYS + e2
    gates = jax.nn.softmax(vals, axis=-1)
    nchunk = T // PEER_CHUNK

    def expert_chunk(args):
        xc, ec, gc = args
        hid = jax.nn.gelu(jnp.einsum('cd,chkd->chk', xc, u_tab[ec]).astype(jnp.float32))
        return jnp.einsum('chk,chkd->cd', (gc * hid).astype(xc.dtype), v_tab[ec])

    out = lax.map(expert_chunk, (xt.reshape(nchunk, PEER_CHUNK, D),
                                 experts.reshape(nchunk, PEER_CHUNK, PEER_HEADS, PEER_TOPK),
                                 gates.reshape(nchunk, PEER_CHUNK, PEER_HEADS, PEER_TOPK)))
    return out.reshape(B, S, D)


def setup_inputs(seed: int = 0) -> dict:
    key = jax.random.key(seed)
    ks = jax.random.split(key, 24)
    f32 = jnp.float32
    L, D = DEPTH, D_MODEL

    def nrm(k, shape, scale):
        return jax.random.normal(k, shape, f32) * scale

    offs = jax.random.randint(ks[1], (BATCH, 1), 0, 1024, dtype=jnp.int32)
    positions = offs + jnp.arange(SEQ, dtype=jnp.int32)[None, :]
    return {
        "x": nrm(ks[0], (BATCH, SEQ, D), 1.0),
        "positions": positions,
        "norm1_g": 1.0 + nrm(ks[2], (L, D), 0.02),
        "w_in": nrm(ks[3], (L, D, IN_COLS), D ** -0.5),
        "gla_w_decay": nrm(ks[4], (L, GLA_LOWRANK, GLA_QK_COLS), GLA_LOWRANK ** -0.5),
        "gla_b_decay": nrm(ks[5], (L, GLA_QK_COLS), 0.1),
        "gla_norm_g": 1.0 + nrm(ks[6], (L, GLA_DV), 0.02),
        "nsa_cmp_pos_k": nrm(ks[7], (L, CMP_BLOCK, NSA_DH), 0.02),
        "nsa_cmp_pos_v": nrm(ks[8], (L, CMP_BLOCK, NSA_DH), 0.02),
        "nsa_cmp_k_w1": nrm(ks[9], (L, CMP_BLOCK * NSA_DH, NSA_DH), (CMP_BLOCK * NSA_DH) ** -0.5),
        "nsa_cmp_k_w2": nrm(ks[10], (L, NSA_DH, NSA_DH), NSA_DH ** -0.5),
        "nsa_cmp_v_w1": nrm(ks[11], (L, CMP_BLOCK * NSA_DH, NSA_DH), (CMP_BLOCK * NSA_DH) ** -0.5),
        "nsa_cmp_v_w2": nrm(ks[12], (L, NSA_DH, NSA_DH), NSA_DH ** -0.5),
        "w_up_gla": nrm(ks[13], (L, GLA_V_COLS, D), GLA_V_COLS ** -0.5),
        "w_up_nsa": nrm(ks[14], (L, NSA_Q_COLS, D), NSA_Q_COLS ** -0.5),
        "w_out": nrm(ks[15], (L, D, D), D ** -0.5),
        "norm2_g": 1.0 + nrm(ks[16], (L, D), 0.02),
        "peer_w_q": nrm(ks[17], (L, D, PEER_HEADS * PEER_DKEY), D ** -0.5),
        "peer_sub_k1": nrm(ks[18], (L, PEER_HEADS, PEER_NKEYS, PEER_DKEY // 2), (PEER_DKEY // 2) ** -0.5),
        "peer_sub_k2": nrm(ks[19], (L, PEER_HEADS, PEER_NKEYS, PEER_DKEY // 2), (PEER_DKEY // 2) ** -0.5),
        "peer_u": nrm(ks[20], (L, PEER_EXPERTS, D), D ** -0.5),
        "peer_v": nrm(ks[21], (L, PEER_EXPERTS, D), PEER_HEADS ** -0.5),
        "final_g": 1.0 + nrm(ks[22], (D,), 0.02),
    }


def reference(x, positions, norm1_g, w_in, gla_w_decay, gla_b_decay, gla_norm_g, nsa_cmp_pos_k, nsa_cmp_pos_v,
              nsa_cmp_k_w1, nsa_cmp_k_w2, nsa_cmp_v_w1, nsa_cmp_v_w2, w_up_gla, w_up_nsa, w_out, norm2_g,
              peer_w_q, peer_sub_k1, peer_sub_k2, peer_u, peer_v, final_g):
    B, S, D = x.shape
    widths = [NSA_Q_COLS] + [NSA_KV_COLS] * 6 + [NSA_GATE_COLS, GLA_QK_COLS, GLA_QK_COLS, GLA_V_COLS,
                                                 GLA_LOWRANK, GLA_V_COLS, MERGE_COLS, MERGE_COLS]
    offsets = np.cumsum(widths)[:-1].tolist()
    for l in range(DEPTH):
        h = rmsnorm(x, norm1_g[l])
        proj = h @ w_in[l]
        (nq, kcm, vcm, ksl, vsl, kwn, vwn, ngate, gq, gk, gv, glr, gr, gate_a, gate_b) = jnp.split(proj, offsets, axis=-1)

        log_a = jax.nn.log_sigmoid((glr @ gla_w_decay[l] + gla_b_decay[l]).astype(jnp.float32)) / GLA_TAU
        y_gla = gla_mixer(gq.reshape(B, S, GLA_HEADS, GLA_DK), gk.reshape(B, S, GLA_HEADS, GLA_DK),
                          gv.reshape(B, S, GLA_HEADS, GLA_DV), log_a.reshape(B, S, GLA_HEADS, GLA_DK),
                          gr, gla_norm_g[l])

        def kv(t):
            return t.reshape(B, S, NSA_GROUPS, NSA_DH)
        q_n = partial_rope(nq.reshape(B, S, NSA_HEADS, NSA_DH), positions)
        y_nsa = nsa_mixer(q_n, partial_rope(kv(kcm), positions), kv(vcm), partial_rope(kv(ksl), positions), kv(vsl),
                          partial_rope(kv(kwn), positions), kv(vwn), ngate,
                          nsa_cmp_pos_k[l], nsa_cmp_pos_v[l], nsa_cmp_k_w1[l], nsa_cmp_k_w2[l],
                          nsa_cmp_v_w1[l], nsa_cmp_v_w2[l])

        ga = jax.nn.sigmoid(gate_a.astype(jnp.float32))
        gb = jax.nn.sigmoid(gate_b.astype(jnp.float32))
        merged = (ga * (y_gla @ w_up_gla[l]) + gb * (y_nsa @ w_up_nsa[l])).astype(x.dtype)
        x = x + merged @ w_out[l]

        h2 = rmsnorm(x, norm2_g[l])
        x = x + peer(h2, peer_w_q[l], peer_sub_k1[l], peer_sub_k2[l], peer_u[l], peer_v[l])
    return rmsnorm(x, final_g)
```

```cpp
#include <hip/hip_runtime.h>
#include <hip/hip_cooperative_groups.h>
#include <cstdio>
#include <cstdint>
#include <cmath>

typedef unsigned short bf16_t;
__host__ __device__ __forceinline__ float bf2f(bf16_t v) { union { unsigned u; float f; } c; c.u = (unsigned)v << 16; return c.f; }
__host__ __device__ __forceinline__ bf16_t f2bf(float f) { union { unsigned u; float f; } c; c.f = f; unsigned u = c.u; return (bf16_t)((u + 0x7fffu + ((u >> 16) & 1u)) >> 16); }

constexpr int BATCH = 4, SEQ = 4096, DM = 2048, T = BATCH * SEQ;
constexpr int NG = 4, HPG = 4, NH = 16, DH = 128;
constexpr int GH = 4, GDK = 128, GDV = 256;
constexpr int NCMP = 255, NSLC = 64;
constexpr int IN_COLS = 12352, NP = 12544;
constexpr float EPS = 1e-6f;
constexpr int PH = 8, PNK = 128, PTOPK = 16;
constexpr float ATT_SCALE = 0.08838834764831845f;

constexpr size_t MiB = 1u << 20;
constexpr size_t WS_CTL = 0;
constexpr size_t WS_ROPE = 1 * MiB;
constexpr size_t WS_SMALL = 3 * MiB;
constexpr size_t WS_W1T = 4 * MiB;
constexpr size_t WS_KC = 6 * MiB;
constexpr size_t WS_VC = 7 * MiB;
constexpr size_t WS_SMB = 513 * MiB;
constexpr size_t WS_WINT = 16 * MiB;
constexpr size_t WS_HB = 65 * MiB;
constexpr size_t WS_QY = 129 * MiB;
constexpr size_t WS_KV = 193 * MiB;
constexpr size_t WS_GQK = 289 * MiB;
constexpr size_t WS_GV = 321 * MiB;
constexpr size_t WS_GR = 353 * MiB;
constexpr size_t WS_GAB = 385 * MiB;
constexpr size_t WS_END = 529 * MiB;
constexpr size_t WS_ST = 16 * MiB;
constexpr size_t WS_WGT = 80 * MiB, WS_WNT = 84 * MiB, WS_WOT = 92 * MiB, WS_WQT = 100 * MiB;
constexpr size_t WS_TMP = 16 * MiB;
constexpr size_t WS_MERGED = 193 * MiB;
constexpr size_t WS_XB = 289 * MiB;
constexpr size_t WS_QP = 16 * MiB;
constexpr size_t WS_UB = 385 * MiB;

__host__ __device__ __forceinline__ int src_col(int np) {
  if (np < 5120) return np;
  if (np < 5632) return 5168 + (np - 5120);
  if (np < 6144) return 5680 + (np - 5632);
  if (np < 7168) return 6192 + (np - 6144);
  if (np < 8192) return 7232 + (np - 7168);
  if (np < 12288) { const int q = np - 8192; return 8256 + ((q >> 7) & 1) * 2048 + (q >> 8) * 128 + (q & 127); }
  if (np < 12336) return 5120 + (np - 12288);
  if (np < 12352) return 7216 + (np - 12336);
  return -1;
}
__device__ __forceinline__ float sigmoidf_(float x) { return 1.f / (1.f + __expf(-x)); }
__device__ __forceinline__ float gelu_tanh(float x) { return 0.5f * x * (1.f + tanhf(0.7978845608028654f * (x + 0.044715f * x * x * x))); }
__device__ __forceinline__ float wave_sum(float v) {
#pragma unroll
  for (int o = 32; o >= 1; o >>= 1) v += __shfl_xor(v, o);
  return v;
}
__device__ __forceinline__ float wave_max(float v) {
#pragma unroll
  for (int o = 32; o >= 1; o >>= 1) v = fmaxf(v, __shfl_xor(v, o));
  return v;
}

namespace pg8 {
#define PG8_LAS __attribute__((address_space(3)))
typedef short bf16x8 __attribute__((ext_vector_type(8)));
typedef float f32x4 __attribute__((ext_vector_type(4)));
typedef unsigned u32x4 __attribute__((ext_vector_type(4)));
typedef int v4i_t __attribute__((ext_vector_type(4)));
typedef int v8i_t __attribute__((ext_vector_type(8)));
constexpr int BM = 256, BK = 64, HALF = 128, HTB = HALF * BK * 2  , STAGE_BYTES = 8 * HTB, NXCD = 8, WGM = 4;

__host__ __device__ __forceinline__ int lds_byte(int r, int c) { const int st = (r >> 4) * 2 + (c >> 5), rr = r & 15, cc = c & 31, ob = rr * 64 + cc * 2; return st * 1024 + (ob ^ (((ob >> 9) & 1) << 5)); }
__host__ __device__ __forceinline__ void stage_rc(int b, int& R, int& C) { const int st = b / 1024, sb = b % 1024, swz = sb ^ (((sb >> 9) & 1) << 5); R = (st >> 1) * 16 + swz / 64; C = (st & 1) * 32 + (swz % 64) / 2; }
__host__ __device__ __forceinline__ int perm32(int rho) { const int n = rho >> 4, i = rho & 15; return 8 * (i >> 2) + 4 * n + (i & 3); }

struct Unit { int pm, pn, koff; };
struct Gemm { const bf16_t* A; const bf16_t* Bt; int M, N, K, ld; };

struct StaticOrder {
    int nM, nN, nwg, G, c;
    __host__ __device__ void init(int M, int N, int G_, int c_) { nM = M / BM; nN = N / BM; nwg = nM * nN; G = G_; c = c_; }
    __host__ __device__ __forceinline__ bool next(int i, Unit& u) const {
        const long L = (long)i * G + c; if (L >= nwg) return false;
        int wgid = (int)L; { const int q = nwg / NXCD, r = nwg % NXCD, xcd = wgid % NXCD, off = wgid / NXCD; wgid = (xcd < r ? xcd * (q + 1) : r * (q + 1) + (xcd - r) * q) + off; }
        const int nig = WGM * nN, gid = wgid / nig, fm = gid * WGM, gsz = (nM - fm) < WGM ? (nM - fm) : WGM;
        u.pm = fm + ((wgid % nig) % gsz); u.pn = (wgid % nig) / gsz; u.koff = 0; return true;
    }
    __device__ __forceinline__ void a_ready(const Unit&) const {}
    __device__ __forceinline__ void done(const Unit&) const {}
};


__device__ __forceinline__ unsigned cvt_pk_bf16(float lo, float hi) { unsigned r; asm volatile("v_cvt_pk_bf16_f32 %0, %1, %2" : "=v"(r) : "v"(lo), "v"(hi)); return r; }
__device__ __forceinline__ float bflo(unsigned w) { return __uint_as_float(w << 16); }
__device__ __forceinline__ float bfhi(unsigned w) { return __uint_as_float(w & 0xffff0000u); }
__device__ __forceinline__ unsigned long long bf8_to_f8(const bf16x8 v, const float sc) {
    typedef unsigned u4_t __attribute__((ext_vector_type(4))); const u4_t w = __builtin_bit_cast(u4_t, v);
#define F8C(x) __builtin_amdgcn_fmed3f((x) * sc, -448.f, 448.f)
    int p0 = __builtin_amdgcn_cvt_pk_fp8_f32(F8C(bflo(w.x)), F8C(bfhi(w.x)), 0, false); p0 = __builtin_amdgcn_cvt_pk_fp8_f32(F8C(bflo(w.y)), F8C(bfhi(w.y)), p0, true);
    int p1 = __builtin_amdgcn_cvt_pk_fp8_f32(F8C(bflo(w.z)), F8C(bfhi(w.z)), 0, false); p1 = __builtin_amdgcn_cvt_pk_fp8_f32(F8C(bflo(w.w)), F8C(bfhi(w.w)), p1, true);
#undef F8C
    return (unsigned long long)(unsigned)p0 | ((unsigned long long)(unsigned)p1 << 32);
}
__device__ __forceinline__ float sigm(float x) { return __builtin_amdgcn_rcpf(1.f + __builtin_amdgcn_exp2f(-1.4426950408889634f * x)); }
struct SplitKOrder { int G, c;
    __device__ __forceinline__ bool next(int i, Unit& u) const { const int L = i * G + c; if (L >= 256) return false; u.pm = L >> 2; u.pn = 0; u.koff = (L & 3) * 512; return true; }
    __device__ __forceinline__ void a_ready(const Unit&) const {}
    __device__ __forceinline__ void done(const Unit&) const {}
};
struct EpiSlab { static constexpr bool PERM = true, AFTER_DRAIN = false; float* smb4;
    __device__ __forceinline__ void operator()(const f32x4 (&acc)[2][2][4][2], const Unit& u, int wr, int wc, int fr, int fq) const {
        if (wc >= 2) return;
        float* base = smb4 + (size_t)(u.koff >> 9) * T * 64;
        const int row0 = u.pm * BM + wr * 64 + fr, col0 = wc * 32 + 8 * fq;
#pragma unroll
        for (int ai = 0; ai < 2; ++ai)
#pragma unroll
            for (int m = 0; m < 4; ++m) { float* rowp = base + (size_t)(row0 + ai * HALF + m * 16) * 64 + col0;
                *(f32x4*)rowp = acc[ai][0][m][0]; *(f32x4*)(rowp + 4) = acc[ai][0][m][1]; }
    }
};
struct EpiRoute { static constexpr bool PERM = true, AFTER_DRAIN = false; unsigned char* ws;
    __device__ __forceinline__ void operator()(const f32x4 (&acc)[2][2][4][2], const Unit& u, int wr, int wc, int fr, int fq) const {
        const int np0 = u.pn * BM; size_t boff; int ld, c0;
        if (np0 < 2048) { boff = WS_QY; ld = 2048; c0 = np0; } else if (np0 < 5120) { boff = WS_KV; ld = 3072; c0 = np0 - 2048; } else if (np0 < 6144) { boff = WS_GQK; ld = 1024; c0 = np0 - 5120; }
        else if (np0 < 7168) { boff = WS_GV; ld = 1024; c0 = np0 - 6144; } else if (np0 < 8192) { boff = WS_GR; ld = 1024; c0 = np0 - 7168; }
        else { boff = WS_GAB; ld = 4096; c0 = np0 - 8192; }
        bf16_t* base = (bf16_t*)(ws + boff);
        const int row0 = u.pm * BM + wr * 64 + fr, col0 = c0 + wc * 32 + 8 * fq;
        const bool rope = (wc == 0) && ((np0 < 2048) || (np0 >= 3072 && np0 < 3584) || (np0 >= 4096 && np0 < 4608));
        const float* tab = (const float*)(ws + WS_ROPE);
#pragma unroll
        for (int ai = 0; ai < 2; ++ai)
#pragma unroll
            for (int m = 0; m < 4; ++m) { const size_t row = (size_t)(row0 + ai * HALF + m * 16); bf16_t* rowp = base + row * ld + col0;
                f32x4 t0 = {1.f, 0.f, 1.f, 0.f}, t1 = t0, t2 = t0, t3 = t0;
                if (rope) { const f32x4* tb = (const f32x4*)(tab + (row * 16 + 8 * (fq & 1)) * 2); t0 = tb[0]; t1 = tb[1]; t2 = tb[2]; t3 = tb[3]; }
#pragma unroll
                for (int bj = 0; bj < 2; ++bj) { f32x4 v0 = acc[ai][bj][m][0], v1 = acc[ai][bj][m][1];
                    if (rope) { f32x4 p0, p1;
#pragma unroll
                        for (int e = 0; e < 4; ++e) { p0[e] = __shfl_xor(v0[e], 32); p1[e] = __shfl_xor(v1[e], 32); }
                        const float sg = (fq < 2) ? -1.f : 1.f;
                        v0[0] = v0[0] * t0[0] + sg * p0[0] * t0[1]; v0[1] = v0[1] * t0[2] + sg * p0[1] * t0[3]; v0[2] = v0[2] * t1[0] + sg * p0[2] * t1[1]; v0[3] = v0[3] * t1[2] + sg * p0[3] * t1[3];
                        v1[0] = v1[0] * t2[0] + sg * p1[0] * t2[1]; v1[1] = v1[1] * t2[2] + sg * p1[1] * t2[3]; v1[2] = v1[2] * t3[0] + sg * p1[2] * t3[1]; v1[3] = v1[3] * t3[2] + sg * p1[3] * t3[3]; }
                    u32x4 w; w.x = cvt_pk_bf16(v0[0], v0[1]); w.y = cvt_pk_bf16(v0[2], v0[3]); w.z = cvt_pk_bf16(v1[0], v1[1]); w.w = cvt_pk_bf16(v1[2], v1[3]);
                    *(u32x4*)(rowp + bj * HALF) = w; } }
    }
};
struct EpiGateLogits { static constexpr bool PERM = true, AFTER_DRAIN = false; bf16_t* rr; bf16_t* sb;
    __device__ __forceinline__ void operator()(const f32x4 (&acc)[2][2][4][2], const Unit& u, int wr, int wc, int fr, int fq) const {
        const int row0 = u.pm * BM + wr * 64 + fr, ch0 = u.pn * 128 + wc * 32 + 8 * fq; const float sc = -1.f / 64.f;
#pragma unroll
        for (int ai = 0; ai < 2; ++ai)
#pragma unroll
            for (int m = 0; m < 4; ++m) { const size_t off = (size_t)(row0 + ai * HALF + m * 16) * 2048 + ch0; float r[8], b[8];
#pragma unroll
                for (int n = 0; n < 2; ++n)
#pragma unroll
                    for (int j = 0; j < 4; ++j) { const float ea = __expf(acc[ai][0][m][n][j] * sc), eb = __expf(acc[ai][1][m][n][j] * sc); b[4 * n + j] = __builtin_amdgcn_rcpf(1.f + eb); r[4 * n + j] = (1.f + eb) * __builtin_amdgcn_rcpf(1.f + ea); }
                u32x4 w; w.x = cvt_pk_bf16(r[0], r[1]); w.y = cvt_pk_bf16(r[2], r[3]); w.z = cvt_pk_bf16(r[4], r[5]); w.w = cvt_pk_bf16(r[6], r[7]); *(u32x4*)(rr + off) = w;
                u32x4 x; x.x = cvt_pk_bf16(b[0], b[1]); x.y = cvt_pk_bf16(b[2], b[3]); x.z = cvt_pk_bf16(b[4], b[5]); x.w = cvt_pk_bf16(b[6], b[7]); *(u32x4*)(sb + off) = x; }
    }
};
struct EpiGateFused { static constexpr bool PERM = true, AFTER_DRAIN = false; static constexpr int MID_T = 8; unsigned char* ws; float sc;
    __device__ __forceinline__ void mid(f32x4 (&acc)[2][2][4][2], const Unit& u, int wr, int wc, int fr, int fq) const {
        const bf16_t* rr = (const bf16_t*)(ws + WS_GAB);
        int ln_ = threadIdx.x & 63; asm volatile("" : "+v"(ln_));
        const int row0 = u.pm * BM + wr * 64 + (ln_ & 15), col0 = u.pn * BM + wc * 32 + 8 * (ln_ >> 4);
#pragma unroll
        for (int ai = 0; ai < 2; ++ai) { u32x4 gq[4][2];
#pragma unroll
            for (int m = 0; m < 4; ++m)
#pragma unroll
                for (int bj = 0; bj < 2; ++bj) gq[m][bj] = *(const u32x4*)(rr + (size_t)(row0 + ai * HALF + m * 16) * 2048 + col0 + bj * HALF);
            __builtin_amdgcn_sched_barrier(0);
#pragma unroll
            for (int m = 0; m < 4; ++m)
#pragma unroll
                for (int bj = 0; bj < 2; ++bj) { const u32x4 g = gq[m][bj]; f32x4& v0 = acc[ai][bj][m][0]; f32x4& v1 = acc[ai][bj][m][1];
                    v0[0] *= bflo(g.x); v0[1] *= bfhi(g.x); v0[2] *= bflo(g.y); v0[3] *= bfhi(g.y); v1[0] *= bflo(g.z); v1[1] *= bfhi(g.z); v1[2] *= bflo(g.w); v1[3] *= bfhi(g.w); }
            __builtin_amdgcn_sched_barrier(0); }
    }
    __device__ __forceinline__ void operator()(const f32x4 (&acc)[2][2][4][2], const Unit& u, int wr, int wc, int fr, int fq) const {
        const bf16_t* sb = (const bf16_t*)(ws + WS_GAB + 64 * MiB); bf16_t* outp = (bf16_t*)(ws + WS_MERGED);
        const int row0 = u.pm * BM + wr * 64 + fr, col0 = u.pn * BM + wc * 32 + 8 * fq;
#pragma unroll
        for (int ai = 0; ai < 2; ++ai) { u32x4 gq[4][2];
#pragma unroll
            for (int m = 0; m < 4; ++m)
#pragma unroll
                for (int bj = 0; bj < 2; ++bj) gq[m][bj] = *(const u32x4*)(sb + (size_t)(row0 + ai * HALF + m * 16) * 2048 + col0 + bj * HALF);
            __builtin_amdgcn_sched_barrier(0);
#pragma unroll
            for (int m = 0; m < 4; ++m) { const size_t row = (size_t)(row0 + ai * HALF + m * 16);
#pragma unroll
                for (int bj = 0; bj < 2; ++bj) { const u32x4 g = gq[m][bj]; const f32x4 v0 = acc[ai][bj][m][0] * sc, v1 = acc[ai][bj][m][1] * sc;
                    u32x4 w; w.x = cvt_pk_bf16(v0[0] * bflo(g.x), v0[1] * bfhi(g.x)); w.y = cvt_pk_bf16(v0[2] * bflo(g.y), v0[3] * bfhi(g.y));
                    w.z = cvt_pk_bf16(v1[0] * bflo(g.z), v1[1] * bfhi(g.z)); w.w = cvt_pk_bf16(v1[2] * bflo(g.w), v1[3] * bfhi(g.w));
                    *(u32x4*)(outp + row * 2048 + col0 + bj * HALF) = w; } }
            __builtin_amdgcn_sched_barrier(0); }
    }
};
template <int STEP> struct EpiGate { static constexpr bool PERM = true, AFTER_DRAIN = false; unsigned char* ws; float sc;
    __device__ __forceinline__ void operator()(const f32x4 (&acc)[2][2][4][2], const Unit& u, int wr, int wc, int fr, int fq) const {
        const bf16_t* gab = (const bf16_t*)(ws + WS_GAB) + (STEP == 2 ? 2048 : 0); const bf16_t* tin = (const bf16_t*)(ws + WS_TMP); bf16_t* outp = (bf16_t*)(ws + (STEP == 2 ? WS_MERGED : WS_TMP));
        const int row0 = u.pm * BM + wr * 64 + fr, col0 = u.pn * BM + wc * 32 + 8 * fq;
#pragma unroll
        for (int ai = 0; ai < 2; ++ai) {
            u32x4 gq[4][2], tq[4][2];
#pragma unroll
            for (int m = 0; m < 4; ++m)
#pragma unroll
                for (int bj = 0; bj < 2; ++bj) { const size_t row = (size_t)(row0 + ai * HALF + m * 16); const int col = col0 + bj * HALF;
                    gq[m][bj] = *(const u32x4*)(gab + row * 4096 + col); if (STEP == 2) tq[m][bj] = *(const u32x4*)(tin + row * 2048 + col); }
            __builtin_amdgcn_sched_barrier(0);
#pragma unroll
            for (int m = 0; m < 4; ++m) { const size_t row = (size_t)(row0 + ai * HALF + m * 16);
#pragma unroll
                for (int bj = 0; bj < 2; ++bj) { const int col = col0 + bj * HALF; const f32x4 v0 = acc[ai][bj][m][0] * sc, v1 = acc[ai][bj][m][1] * sc; const u32x4 g = gq[m][bj];
                    float o0 = v0[0] * sigm(bflo(g.x)), o1 = v0[1] * sigm(bfhi(g.x)), o2 = v0[2] * sigm(bflo(g.y)), o3 = v0[3] * sigm(bfhi(g.y));
                    float o4 = v1[0] * sigm(bflo(g.z)), o5 = v1[1] * sigm(bfhi(g.z)), o6 = v1[2] * sigm(bflo(g.w)), o7 = v1[3] * sigm(bfhi(g.w));
                    if (STEP == 2) { const u32x4 t = tq[m][bj];
                        o0 += bflo(t.x); o1 += bfhi(t.x); o2 += bflo(t.y); o3 += bfhi(t.y); o4 += bflo(t.z); o5 += bfhi(t.z); o6 += bflo(t.w); o7 += bfhi(t.w); }
                    u32x4 w; w.x = cvt_pk_bf16(o0, o1); w.y = cvt_pk_bf16(o2, o3); w.z = cvt_pk_bf16(o4, o5); w.w = cvt_pk_bf16(o6, o7);
                    *(u32x4*)(outp + row * 2048 + col) = w; } }
            __builtin_amdgcn_sched_barrier(0); }
    }
};
struct EpiOut { static constexpr bool PERM = false, AFTER_DRAIN = false; unsigned char* ws; const float* x; float* out;
    __device__ __forceinline__ void operator()(const f32x4 (&acc)[2][2][4][2], const Unit& u, int wr, int wc, int fr, int fq) const {
        typedef unsigned u32x2v __attribute__((ext_vector_type(2)));
        bf16_t* xb = (bf16_t*)(ws + WS_XB); float* ssqp = (float*)(ws + WS_W1T);
        const int row0 = u.pm * BM + wr * 64 + fr, col0 = u.pn * BM + wc * 32 + 4 * fq;
#pragma unroll
        for (int ai = 0; ai < 2; ++ai) {
            f32x4 xv[4][2][2];
#pragma unroll
            for (int m = 0; m < 4; ++m)
#pragma unroll
                for (int bj = 0; bj < 2; ++bj)
#pragma unroll
                    for (int n = 0; n < 2; ++n) xv[m][bj][n] = *(const f32x4*)(x + (size_t)(row0 + ai * HALF + m * 16) * 2048 + col0 + bj * HALF + n * 16);
            __builtin_amdgcn_sched_barrier(0);
#pragma unroll
            for (int m = 0; m < 4; ++m) { const size_t row = (size_t)(row0 + ai * HALF + m * 16); float ss = 0.f;
#pragma unroll
                for (int bj = 0; bj < 2; ++bj)
#pragma unroll
                    for (int n = 0; n < 2; ++n) { const size_t off = row * 2048 + col0 + bj * HALF + n * 16; const f32x4 o = xv[m][bj][n] + acc[ai][bj][m][n];
                        u32x2v w; w.x = cvt_pk_bf16(o[0], o[1]); w.y = cvt_pk_bf16(o[2], o[3]); *(u32x2v*)(xb + off) = w;
                        ss += (o[0] * o[0] + o[1] * o[1]) + (o[2] * o[2] + o[3] * o[3]); }
                ss += __shfl_xor(ss, 16); ss += __shfl_xor(ss, 32);
                if (fq == 0) ssqp[row * 32 + u.pn * 4 + wc] = ss; }
            __builtin_amdgcn_sched_barrier(0); }
    }
};
struct EpiQP { static constexpr bool PERM = false, AFTER_DRAIN = false; unsigned char* ws; const float* rs_tab;
    __device__ __forceinline__ void operator()(const f32x4 (&acc)[2][2][4][2], const Unit& u, int wr, int wc, int fr, int fq) const {
        float* qp = (float*)(ws + WS_QP);
        const int rl0 = wr * 64 + fr, col0 = u.pn * BM + wc * 32 + 4 * fq;
#pragma unroll
        for (int ai = 0; ai < 2; ++ai)
#pragma unroll
            for (int m = 0; m < 4; ++m) { const int rl = rl0 + ai * HALF + m * 16; const size_t row = (size_t)(u.pm * BM + rl); const float rs = rs_tab[rl];
#pragma unroll
                for (int bj = 0; bj < 2; ++bj)
#pragma unroll
                    for (int n = 0; n < 2; ++n) *(f32x4*)(qp + row * 1024 + col0 + bj * HALF + n * 16) = acc[ai][bj][m][n] * rs; }
    }
};

template <class...> struct void_tt { typedef void type; };
template <class E, class = void> struct mid_t { static constexpr int v = 0; };
template <class E> struct mid_t<E, typename void_tt<decltype(E::MID_T)>::type> { static constexpr int v = E::MID_T; };
template <class Epi, class Sched, bool ALIGN_EPI = false, bool SP2 = false, bool F8 = false>
__device__ __forceinline__ void gemm_phase(PG8_LAS unsigned char* lds, const Gemm g, const Sched& S, const Epi& E) {
    const int tid = threadIdx.x, wid = __builtin_amdgcn_readfirstlane(tid >> 6), lane = tid & 63, wr = wid >> 2, wc = wid & 3, fr = lane & 15, fq = lane >> 4;
    const int K = g.K, nt = K / BK;
    unsigned voffA[2], voffB[2];
#pragma unroll
    for (int i = 0; i < 2; ++i) { int R, C; stage_rc(tid * 16 + i * 8192, R, C); const int Rb = Epi::PERM ? ((R & ~31) + perm32(R & 31)) : R;
        voffA[i] = (unsigned)(R * g.ld + C) * 2u; voffB[i] = (unsigned)(Rb * g.ld + C) * 2u; }
    const size_t kstep = (size_t)(BK * 2);
    const size_t hstep = (size_t)HALF * g.ld * 2;
    const size_t tstep = 2 * hstep;
    const unsigned ldsw = (unsigned)wid * 1024u;
    const int aoff = lds_byte(wr * 64 + fr, F8 ? fq * 16 : fq * 8), boff = lds_byte(wc * 32 + fr, F8 ? fq * 16 : fq * 8);
#define PG8_SA(b, h) (((b) * 2 + (h)) * HTB)
#define PG8_SB(b, h) ((4 + (b) * 2 + (h)) * HTB)
#define PG8_STAGE(bufoff, gbase, voff) do { _Pragma("unroll") for (int _i = 0; _i < 2; ++_i) \
        __builtin_amdgcn_global_load_lds((const unsigned*)((const char*)(gbase) + (voff)[_i]), (PG8_LAS unsigned*)(lds + (bufoff) + ldsw + _i * 8192), 16, 0, 0); } while (0)
#define PG8_LDA(dst, b, h) do { if constexpr (F8) { _Pragma("unroll") for (int m = 0; m < 4; ++m) dst##8[m] = *(const PG8_LAS v8i_t*)(lds + PG8_SA(b, h) + aoff + m * 2048); } \
        else { _Pragma("unroll") for (int m = 0; m < 4; ++m) _Pragma("unroll") for (int k = 0; k < 2; ++k) dst[m][k] = *(const PG8_LAS bf16x8*)(lds + PG8_SA(b, h) + aoff + m * 2048 + k * 1024); } } while (0)
#define PG8_LDB(dst, b, h) do { if constexpr (F8) { _Pragma("unroll") for (int n = 0; n < 2; ++n) dst##8[n] = *(const PG8_LAS v8i_t*)(lds + PG8_SB(b, h) + boff + n * 2048); } \
        else { _Pragma("unroll") for (int n = 0; n < 2; ++n) _Pragma("unroll") for (int k = 0; k < 2; ++k) dst[n][k] = *(const PG8_LAS bf16x8*)(lds + PG8_SB(b, h) + boff + n * 2048 + k * 1024); } } while (0)
#define PG8_MMA(ai, bj, At, Bt) do { __builtin_amdgcn_s_setprio(1); if constexpr (F8) { _Pragma("unroll") for (int m = 0; m < 4; ++m) _Pragma("unroll") for (int n = 0; n < 2; ++n) \
          asm volatile("v_mfma_scale_f32_16x16x128_f8f6f4 %0, %1, %2, %0, %3, %3 op_sel_hi:[0,0,0]" : "+v"(acc[ai][bj][m][n]) : "v"(Bt##8[n]), "v"(At##8[m]), "v"(scale1)); } \
        else { _Pragma("unroll") for (int m = 0; m < 4; ++m) _Pragma("unroll") for (int n = 0; n < 2; ++n) _Pragma("unroll") for (int k = 0; k < 2; ++k) \
        acc[ai][bj][m][n] = __builtin_amdgcn_mfma_f32_16x16x32_bf16(Bt[n][k], At[m][k], acc[ai][bj][m][n], 0, 0, 0); } __builtin_amdgcn_s_setprio(0); } while (0)
#define PG8_WAIT_V(n) asm volatile("s_waitcnt vmcnt(" #n ")" ::: "memory")
#define PG8_WAIT_L(n) asm volatile("s_waitcnt lgkmcnt(" #n ")" ::: "memory")
#define PG8_BAR __builtin_amdgcn_s_barrier()
#define PG8_SCHED __builtin_amdgcn_sched_barrier(0)
    Unit cur, nxt; int ui = 0;
    if (!S.next(0, cur)) return;
    f32x4 acc[2][2][4][2];
#pragma unroll
    for (int a = 0; a < 2; ++a)
#pragma unroll
        for (int b = 0; b < 2; ++b)
#pragma unroll
            for (int m = 0; m < 4; ++m)
#pragma unroll
                for (int n = 0; n < 2; ++n) acc[a][b][m][n] = (f32x4){0.f, 0.f, 0.f, 0.f};
    bf16x8 At[4][2], B0[2][2], B1[2][2]; v8i_t At8[4], B08[2], B18[2]; int scale1 = 0x7F7F7F7F; asm volatile("" : "+v"(scale1));
    (void)At8; (void)B08; (void)B18;
    const char* cA = (const char*)g.A + (size_t)cur.pm * tstep + (size_t)cur.koff * 2; const char* cB = (const char*)g.Bt + (size_t)cur.pn * tstep + (size_t)cur.koff * 2;
    S.a_ready(cur);
    if constexpr (SP2) {
        PG8_STAGE(PG8_SB(0, 0), cB, voffB); PG8_STAGE(PG8_SB(0, 1), cB + hstep, voffB); PG8_STAGE(PG8_SA(0, 0), cA, voffA); PG8_STAGE(PG8_SA(0, 1), cA + hstep, voffA);
        if (wr == 1) PG8_BAR;
        PG8_WAIT_V(2); PG8_BAR;
        PG8_STAGE(PG8_SB(1, 0), cB + kstep, voffB); PG8_STAGE(PG8_SA(1, 0), cA + kstep, voffA); PG8_STAGE(PG8_SB(1, 1), cB + hstep + kstep, voffB);
        PG8_WAIT_V(6); PG8_BAR;
    } else {
        PG8_STAGE(PG8_SB(0, 0), cB, voffB); PG8_STAGE(PG8_SA(0, 0), cA, voffA); PG8_STAGE(PG8_SB(0, 1), cB + hstep, voffB); PG8_STAGE(PG8_SA(0, 1), cA + hstep, voffA);
        if (wr == 1) PG8_BAR;
        PG8_WAIT_V(4); PG8_BAR;
        PG8_STAGE(PG8_SB(1, 0), cB + kstep, voffB); PG8_STAGE(PG8_SA(1, 0), cA + kstep, voffA); PG8_STAGE(PG8_SB(1, 1), cB + hstep + kstep, voffB);
        PG8_WAIT_V(6); PG8_BAR;
    }
    for (;;) {
        const bool has_next = S.next(ui + 1, nxt);
        const char* nA = has_next ? (const char*)g.A + (size_t)nxt.pm * tstep + (size_t)nxt.koff * 2 : cA; const char* nB = has_next ? (const char*)g.Bt + (size_t)nxt.pn * tstep + (size_t)nxt.koff * 2 : cB;
        for (int t = 0; t < nt; t += 2) {
            if constexpr (mid_t<Epi>::v > 0) { if (t == mid_t<Epi>::v) {
                if constexpr (ALIGN_EPI) { if (wr == 0) PG8_BAR; }
                if constexpr (F8) asm volatile("s_nop 15\n\ts_nop 15" ::: "memory");
                E.mid(acc, cur, wr, wc, fr, fq);
                if constexpr (F8) asm volatile("s_nop 7" ::: "memory");
                if constexpr (ALIGN_EPI) { if (wr == 1) PG8_BAR; } } }
            const bool last = (t == nt - 2);
            const char* a1 = cA + (size_t)(t + 1) * kstep;
            const char* a2 = last ? nA : cA + (size_t)(t + 2) * kstep; const char* b2 = last ? nB : cB + (size_t)(t + 2) * kstep;
            const char* a3 = a2 + kstep; const char* b3 = b2 + kstep;
            if (last && has_next) S.a_ready(nxt);
            if constexpr (SP2) {
            PG8_LDB(B0, 0, 0); PG8_LDB(B1, 0, 1); PG8_SCHED; PG8_LDA(At, 0, 0); PG8_STAGE(PG8_SA(1, 1), a1 + hstep, voffA);
            PG8_WAIT_V(8); PG8_WAIT_L(0); PG8_BAR; PG8_MMA(0, 0, At, B0); PG8_MMA(0, 1, At, B1); PG8_BAR; PG8_SCHED;
            PG8_LDA(At, 0, 1); PG8_STAGE(PG8_SB(0, 0), b2, voffB); PG8_STAGE(PG8_SB(0, 1), b2 + hstep, voffB); PG8_STAGE(PG8_SA(0, 0), a2, voffA);
            PG8_WAIT_V(8); PG8_WAIT_L(0); PG8_BAR; PG8_MMA(1, 0, At, B0); PG8_MMA(1, 1, At, B1); PG8_BAR; PG8_SCHED;
            PG8_LDB(B0, 1, 0); PG8_LDB(B1, 1, 1); PG8_SCHED; PG8_LDA(At, 1, 0); PG8_STAGE(PG8_SA(0, 1), a2 + hstep, voffA);
            PG8_WAIT_V(8); PG8_WAIT_L(0); PG8_BAR; PG8_MMA(0, 0, At, B0); PG8_MMA(0, 1, At, B1); PG8_BAR; PG8_SCHED;
            PG8_LDA(At, 1, 1); PG8_STAGE(PG8_SB(1, 0), b3, voffB); PG8_STAGE(PG8_SB(1, 1), b3 + hstep, voffB); PG8_STAGE(PG8_SA(1, 0), a3, voffA);
            PG8_WAIT_V(8); PG8_WAIT_L(0); PG8_BAR; PG8_MMA(1, 0, At, B0); PG8_MMA(1, 1, At, B1); PG8_BAR; PG8_SCHED;
            } else {
            PG8_LDB(B0, 0, 0); PG8_SCHED; PG8_LDA(At, 0, 0); PG8_STAGE(PG8_SA(1, 1), a1 + hstep, voffA);
            PG8_WAIT_L(8); PG8_BAR; PG8_WAIT_L(0); PG8_MMA(0, 0, At, B0); PG8_BAR; PG8_SCHED;
            PG8_LDB(B1, 0, 1); PG8_STAGE(PG8_SB(0, 0), b2, voffB);
            PG8_BAR; PG8_WAIT_L(0); PG8_MMA(0, 1, At, B1); PG8_BAR;
            PG8_LDA(At, 0, 1); PG8_STAGE(PG8_SA(0, 0), a2, voffA);
            PG8_BAR; PG8_WAIT_L(0); PG8_MMA(1, 0, At, B0); PG8_BAR; PG8_SCHED;
            PG8_STAGE(PG8_SB(0, 1), b2 + hstep, voffB);
            PG8_WAIT_V(6); PG8_BAR; PG8_MMA(1, 1, At, B1); PG8_BAR;
            PG8_LDB(B0, 1, 0); PG8_SCHED; PG8_LDA(At, 1, 0); PG8_STAGE(PG8_SA(0, 1), a2 + hstep, voffA);
            PG8_WAIT_L(8); PG8_BAR; PG8_WAIT_L(0); PG8_MMA(0, 0, At, B0); PG8_BAR; PG8_SCHED;
            PG8_LDB(B1, 1, 1); PG8_STAGE(PG8_SB(1, 0), b3, voffB);
            PG8_BAR; PG8_WAIT_L(0); PG8_MMA(0, 1, At, B1); PG8_BAR;
            PG8_LDA(At, 1, 1); PG8_STAGE(PG8_SA(1, 0), a3, voffA);
            PG8_BAR; PG8_WAIT_L(0); PG8_MMA(1, 0, At, B0); PG8_BAR; PG8_SCHED;
            PG8_STAGE(PG8_SB(1, 1), b3 + hstep, voffB);
            PG8_WAIT_V(6); PG8_BAR; PG8_MMA(1, 1, At, B1); PG8_BAR;
            }
        }
        if constexpr (ALIGN_EPI) { if (wr == 0) PG8_BAR; }
        if constexpr (F8) asm volatile("s_nop 15\n\ts_nop 15" ::: "memory");
        if constexpr (!Epi::AFTER_DRAIN) { E(acc, cur, wr, wc, fr, fq); S.done(cur); }
        if (!has_next) break;
#pragma unroll
        for (int a = 0; a < 2; ++a)
#pragma unroll
            for (int b = 0; b < 2; ++b)
#pragma unroll
                for (int m = 0; m < 4; ++m)
#pragma unroll
                    for (int n = 0; n < 2; ++n) acc[a][b][m][n] = (f32x4){0.f, 0.f, 0.f, 0.f};
        cur = nxt; cA = nA; cB = nB; ++ui;
        if constexpr (ALIGN_EPI) { if (wr == 1) PG8_BAR; }
    }
    PG8_WAIT_V(0);
    if constexpr (!ALIGN_EPI) { if (wr == 0) PG8_BAR; }
    PG8_BAR;
    if constexpr (Epi::AFTER_DRAIN) { E.fused(acc, cur, wr, wc, fr, fq, lds, wid, lane); S.done(cur); }
#undef PG8_SA
#undef PG8_SB
#undef PG8_STAGE
#undef PG8_LDA
#undef PG8_LDB
#undef PG8_MMA
#undef PG8_WAIT_V
#undef PG8_WAIT_L
#undef PG8_BAR
#undef PG8_SCHED
}
}


namespace att {
using bf16x8 = __attribute__((ext_vector_type(8))) short;
using s16x4  = __attribute__((ext_vector_type(4))) short;
using f32x16 = __attribute__((ext_vector_type(16))) float;
using f32x4  = __attribute__((ext_vector_type(4))) float;
using u32x4  = __attribute__((ext_vector_type(4))) unsigned;
constexpr int SHM_V = 16384, SHM_K = 16384;
constexpr int L_V = 0, L_K = 32768, L_WSF = 65536, L_IMPG = 67584, L_IMPE = L_IMPG + 16384, L_IMPF = L_IMPE + 16384, L_OACC = L_IMPG, L_SEL = L_OACC + 65536, L_LIST = L_SEL + 512, L_GATE = 140288  , L_END = L_GATE + 8 * 96 * 4;
static_assert(L_END <= 147456 - 1024, "attention LDS map");
constexpr float C2 = 0.08838834764831845f * 1.4426950408889634f;
#define KSWZ(row, colB) ((row) * 256 + ((colB) ^ (((row) & 7) << 4)))
#define SBAR() __builtin_amdgcn_sched_barrier(0)
__device__ __forceinline__ int crow(int r, int hi) { return (r & 3) + 8 * (r >> 2) + 4 * hi; }
__device__ __forceinline__ unsigned cvtpk(float lo, float hi) { unsigned r; asm volatile("v_cvt_pk_bf16_f32 %0, %1, %2" : "=v"(r) : "v"(lo), "v"(hi)); return r; }
__device__ __forceinline__ float sigm(float x) { return __builtin_amdgcn_rcpf(1.f + __builtin_amdgcn_exp2f(-1.4426950408889634f * x)); }
__device__ __forceinline__ void qkt(f32x16& p0, f32x16& p1, const char* Ks, const bf16x8* qr, int r32, int hi) {
  p0 = f32x16{}; p1 = f32x16{};
#pragma unroll
  for (int d0 = 0; d0 < 8; ++d0) { int cb = (d0 * 16 + hi * 8) * 2;
    bf16x8 b0 = *reinterpret_cast<const bf16x8*>(Ks + KSWZ(r32, cb));
    bf16x8 b1 = *reinterpret_cast<const bf16x8*>(Ks + KSWZ(32 + r32, cb));
    p0 = __builtin_amdgcn_mfma_f32_32x32x16_bf16(b0, qr[d0], p0, 0, 0, 0);
    p1 = __builtin_amdgcn_mfma_f32_32x32x16_bf16(b1, qr[d0], p1, 0, 0, 0); }
}
__device__ __forceinline__ int v_st(int k, int c) { const int kk = (k & ~0xC) | ((k & 4) << 1) | ((k & 8) >> 1); return ((kk >> 3) * 4 + (c >> 5)) * 512 + ((kk & 7) * 32 + (c & 31)) * 2; }
__device__ __forceinline__ int v_rd_base(int lane) { return ((lane & 3) << 3) | (((lane >> 2) & 3) << 6) | (((lane >> 4) & 1) << 5) | (((lane >> 5) & 1) << 8); }
constexpr int v_rd_off(int d0, int ks, int half) { return d0 * 512 + ks * 4096 + half * 2048; }
template <int OFF> __device__ __forceinline__ s16x4 tr_read(int vb) {
  s16x4 r; asm volatile("ds_read_b64_tr_b16 %0, %1 offset:%2" : "=&v"(r) : "v"(vb), "i"(OFF) : "memory"); return r;
}
template <int D0> __device__ __forceinline__ void pv_one(f32x16& od, int vb, bf16x8 pa0, bf16x8 pa1, bf16x8 pa2, bf16x8 pa3) {
  const s16x4 l0 = tr_read<v_rd_off(D0, 0, 0)>(vb), h0 = tr_read<v_rd_off(D0, 0, 1)>(vb), l1 = tr_read<v_rd_off(D0, 1, 0)>(vb), h1 = tr_read<v_rd_off(D0, 1, 1)>(vb);
  const s16x4 l2 = tr_read<v_rd_off(D0, 2, 0)>(vb), h2 = tr_read<v_rd_off(D0, 2, 1)>(vb), l3 = tr_read<v_rd_off(D0, 3, 0)>(vb), h3 = tr_read<v_rd_off(D0, 3, 1)>(vb);
  asm volatile("s_waitcnt lgkmcnt(0)" ::: "memory"); SBAR();
#define PK(L, H) (bf16x8){L[0], L[1], L[2], L[3], H[0], H[1], H[2], H[3]}
  od = __builtin_amdgcn_mfma_f32_32x32x16_bf16(pa0, PK(l0, h0), od, 0, 0, 0);
  od = __builtin_amdgcn_mfma_f32_32x32x16_bf16(pa1, PK(l1, h1), od, 0, 0, 0);
  od = __builtin_amdgcn_mfma_f32_32x32x16_bf16(pa2, PK(l2, h2), od, 0, 0, 0);
  od = __builtin_amdgcn_mfma_f32_32x32x16_bf16(pa3, PK(l3, h3), od, 0, 0, 0);
#undef PK
}
__device__ __forceinline__ void pv_d0(f32x16* o, int vb, bf16x8 pa0, bf16x8 pa1, bf16x8 pa2, bf16x8 pa3) {
  pv_one<0>(o[0], vb, pa0, pa1, pa2, pa3); pv_one<1>(o[1], vb, pa0, pa1, pa2, pa3); pv_one<2>(o[2], vb, pa0, pa1, pa2, pa3); pv_one<3>(o[3], vb, pa0, pa1, pa2, pa3);
}
__device__ __forceinline__ float half_max(float v) { auto rr = __builtin_amdgcn_permlane32_swap(__float_as_uint(v), __float_as_uint(v), false, false); return fmaxf(__uint_as_float(rr[0]), __uint_as_float(rr[1])); }
__device__ __forceinline__ float half_sum(float v) { auto rr = __builtin_amdgcn_permlane32_swap(__float_as_uint(v), __float_as_uint(v), false, false); return __uint_as_float(rr[0]) + __uint_as_float(rr[1]); }
#define PK4(P, BASE, OUT) do { unsigned a0_ = cvtpk(P[BASE + 0], P[BASE + 1]), a1_ = cvtpk(P[BASE + 2], P[BASE + 3]);   \
    unsigned b0_ = cvtpk(P[BASE + 4], P[BASE + 5]), b1_ = cvtpk(P[BASE + 6], P[BASE + 7]);                              \
    auto r0_ = __builtin_amdgcn_permlane32_swap(a0_, b0_, false, false); auto r1_ = __builtin_amdgcn_permlane32_swap(a1_, b1_, false, false); \
    u32x4 w_ = {r0_[0], r1_[0], r0_[1], r1_[1]}; OUT = *reinterpret_cast<bf16x8*>(&w_); } while (0)

struct Stg { bf16x8 vs0, vs1, ks0, ks1; };
template <int MODE>
__device__ __forceinline__ void run_branch(char* lds, const bf16_t* __restrict__ Kp, const bf16_t* __restrict__ Vp, const int pitch, const int* list, const int nt,
                                           const bf16x8 (&qr)[8], f32x16 (&o)[4], float& m_reg, float& l_reg, const int c, const int tk, const int t0,
                                           const unsigned sel_lo, const unsigned sel_hi, const float inv_l, const float gate0) {
  int tid_ = threadIdx.x; asm volatile("" : "+v"(tid_));
  const int tid = tid_, wid = tid >> 6, lane = tid & 63, r32 = lane & 31, hi = lane >> 5;
  char* V_lds = lds + L_V; char* K_lds = lds + L_K;
  float* al_l = (float*)(lds + L_WSF) + wid * 64 + 32;
  float* impG = (float*)(lds + L_IMPG); float* impE = (float*)(lds + L_IMPE);
  const int sr = tid >> 4, sc = (tid & 15) * 8, vst0 = v_st(sr, sc), vst1 = v_st(32 + sr, sc);
  const int vb0 = (int)(uintptr_t)V_lds + v_rd_base(lane);
  Stg sA, sB;
#define SLOAD(st, jj) do { const size_t r0_ = (size_t)(jj) * 64; st.vs0 = *(const bf16x8*)(Vp + (r0_ + sr) * pitch + sc); st.vs1 = *(const bf16x8*)(Vp + (r0_ + 32 + sr) * pitch + sc); \
    st.ks0 = *(const bf16x8*)(Kp + (r0_ + sr) * pitch + sc); st.ks1 = *(const bf16x8*)(Kp + (r0_ + 32 + sr) * pitch + sc); } while (0)
#define SWRITE(bb, st) do { *(bf16x8*)(V_lds + (bb) * SHM_V + vst0) = st.vs0; *(bf16x8*)(V_lds + (bb) * SHM_V + vst1) = st.vs1; const int kc_ = sc * 2; \
    *(bf16x8*)(K_lds + (bb) * SHM_K + KSWZ(sr, kc_)) = st.ks0; *(bf16x8*)(K_lds + (bb) * SHM_K + KSWZ(32 + sr, kc_)) = st.ks1; } while (0)
  if (nt <= 0) return;
  SLOAD(sA, list[0]); if (nt > 1) SLOAD(sB, list[1]);
  SWRITE(0, sA); __syncthreads();
#define TILE_BODY(i, SFREE, SNEXT) do { const int j = list[i]; const int buf = (i) & 1; \
    if ((i) + 2 < nt) SLOAD(SFREE, list[(i) + 2]); \
    SBAR(); \
    tile_math(j, buf); \
    SBAR(); \
    if ((i) + 1 < nt) SWRITE(buf ^ 1, SNEXT); \
    __syncthreads(); } while (0)
  auto tile_math = [&](const int j, const int buf) __attribute__((always_inline)) {
    f32x16 p0, p1;
    qkt(p0, p1, K_lds + buf * SHM_K, qr, r32, hi);
    int klo = 0, khi = 63;
    if (MODE <= 1) { int nmax = (t0 + tk - 31) >> 4; nmax = nmax > 254 ? 254 : nmax; khi = nmax - 64 * j; }
    else if (MODE == 2) { const unsigned bit = (j < 32) ? ((sel_lo >> j) & 1u) : ((sel_hi >> (j - 32)) & 1u); khi = bit ? ((j == c) ? tk : 63) : -1; }
    else { khi = (j == c) ? tk : 63; klo = (j == c - 8) ? tk + 1 : 0; }
    if (__any(klo > 0 || khi < 63)) { const int klo2 = klo - 4 * hi, khi2 = khi - 4 * hi;
#pragma unroll
      for (int r = 0; r < 16; ++r) { const int kc = (r & 3) + 8 * (r >> 2);
        p0[r] = (kc >= klo2 && kc <= khi2) ? p0[r] : -INFINITY; p1[r] = (kc + 32 >= klo2 && kc + 32 <= khi2) ? p1[r] : -INFINITY; }
    }
    if (MODE != 1) {
      float pmax = p0[0];
#pragma unroll
      for (int r = 1; r < 16; ++r) pmax = fmaxf(pmax, p0[r]);
#pragma unroll
      for (int r = 0; r < 16; ++r) pmax = fmaxf(pmax, p1[r]);
      pmax = half_max(pmax);
      const float mn = fmaxf(m_reg, pmax); const float alpha = __builtin_amdgcn_exp2f((m_reg - mn) * C2); m_reg = mn;
      const float mnC = -mn * C2; float ps = 0.f;
#pragma unroll
      for (int r = 0; r < 16; ++r) { p0[r] = __builtin_amdgcn_exp2f(fmaf(p0[r], C2, mnC)); p1[r] = __builtin_amdgcn_exp2f(fmaf(p1[r], C2, mnC)); ps += p0[r] + p1[r]; }
      ps = half_sum(ps); l_reg = l_reg * alpha + ps;
      if (MODE >= 2) {
        if (__any(alpha < 1.f)) { if (hi == 0) al_l[r32] = alpha; asm volatile("s_waitcnt lgkmcnt(0)" ::: "memory");
#pragma unroll
          for (int d = 0; d < 4; ++d)
#pragma unroll
            for (int r = 0; r < 16; ++r) o[d][r] *= al_l[crow(r, hi)];
          asm volatile("s_waitcnt lgkmcnt(0)" ::: "memory"); }
      }
    } else {
      const float mnC = -m_reg * C2;
#pragma unroll
      for (int r = 0; r < 16; ++r) { p0[r] = __builtin_amdgcn_exp2f(fmaf(p0[r], C2, mnC)) * inv_l; p1[r] = __builtin_amdgcn_exp2f(fmaf(p1[r], C2, mnC)) * inv_l; }
#pragma unroll
      for (int q4 = 0; q4 < 4; ++q4) {
        float Ga = 2.f * (p0[4 * q4] + p0[4 * q4 + 1] + p0[4 * q4 + 2]) + p0[4 * q4 + 3], Ea = p0[4 * q4 + 3];
        float Gb = 2.f * (p1[4 * q4] + p1[4 * q4 + 1] + p1[4 * q4 + 2]) + p1[4 * q4 + 3], Eb = p1[4 * q4 + 3];
        Ga += __shfl_xor(Ga, 1); Ga += __shfl_xor(Ga, 2); Ea += __shfl_xor(Ea, 1); Ea += __shfl_xor(Ea, 2);
        Gb += __shfl_xor(Gb, 1); Gb += __shfl_xor(Gb, 2); Eb += __shfl_xor(Eb, 1); Eb += __shfl_xor(Eb, 2);
        if ((r32 & 3) == 0) { const int jl = 16 * j + 2 * q4 + hi; impG[tk * 64 + jl] = Ga; impE[tk * 64 + jl] = Ea; impG[tk * 64 + jl + 8] = Gb; impE[tk * 64 + jl + 8] = Eb; }
      }
#pragma unroll
      for (int r = 0; r < 16; ++r) { p0[r] *= gate0; p1[r] *= gate0; }
    }
    if (MODE >= 1) {
      bf16x8 pa0, pa1, pa2, pa3;
      PK4(p0, 0, pa0); PK4(p0, 8, pa1); PK4(p1, 0, pa2); PK4(p1, 8, pa3);
      SBAR();
      pv_d0(o, vb0 + buf * SHM_V, pa0, pa1, pa2, pa3);
    }
  };
  for (int i = 0; i < nt; i += 2) { TILE_BODY(i, sA, sB); if (i + 1 < nt) TILE_BODY(i + 1, sB, sA); }
#undef TILE_BODY
#undef SLOAD
#undef SWRITE
}
template <int MODE>
__device__ __forceinline__ void run_branch_pipe(char* lds, const bf16_t* __restrict__ Kp, const bf16_t* __restrict__ Vp, const int pitch, const int* list, const int nt,
                                                const bf16x8 (&qr)[8], f32x16 (&o)[4], float& m_reg, float& l_reg, const int c, const int tk,
                                                const unsigned sel_lo, const unsigned sel_hi) {
  int tid_ = threadIdx.x; asm volatile("" : "+v"(tid_));
  const int tid = tid_, wid = tid >> 6, lane = tid & 63, r32 = lane & 31, hi = lane >> 5;
  char* V_lds = lds + L_V; char* K_lds = lds + L_K;
  float* al_l = (float*)(lds + L_WSF) + wid * 64 + 32;
  const int sr = tid >> 4, sc = (tid & 15) * 8, vst0 = v_st(sr, sc), vst1 = v_st(32 + sr, sc);
  const int vb0 = (int)(uintptr_t)V_lds + v_rd_base(lane);
  Stg st;
#define SLOAD(jj) do { const size_t r0_ = (size_t)(jj) * 64; st.vs0 = *(const bf16x8*)(Vp + (r0_ + sr) * pitch + sc); st.vs1 = *(const bf16x8*)(Vp + (r0_ + 32 + sr) * pitch + sc); \
    st.ks0 = *(const bf16x8*)(Kp + (r0_ + sr) * pitch + sc); st.ks1 = *(const bf16x8*)(Kp + (r0_ + 32 + sr) * pitch + sc); } while (0)
#define SWRITE(bb) do { *(bf16x8*)(V_lds + (bb) * SHM_V + vst0) = st.vs0; *(bf16x8*)(V_lds + (bb) * SHM_V + vst1) = st.vs1; const int kc_ = sc * 2; \
    *(bf16x8*)(K_lds + (bb) * SHM_K + KSWZ(sr, kc_)) = st.ks0; *(bf16x8*)(K_lds + (bb) * SHM_K + KSWZ(32 + sr, kc_)) = st.ks1; } while (0)
#define MASK_PART(P0, P1, jt, AL) do { int klo_ = 0, khi_ = 63; bool lsel_ = true; \
    if (MODE == 2) { const unsigned bit_ = ((jt) < 32) ? ((sel_lo >> (jt)) & 1u) : ((sel_hi >> (((jt) - 32) & 31)) & 1u); lsel_ = (bit_ != 0u) && !((jt) & 64); khi_ = ((jt) == c) ? tk : 63; } \
    else { khi_ = ((jt) == c) ? tk : 63; klo_ = ((jt) == c - 8) ? tk + 1 : 0; if ((jt) & 64) khi_ = -1; } \
    if (__any(klo_ > 0 || khi_ < 63)) { const int klo2_ = klo_ - 4 * hi, khi2_ = khi_ - 4 * hi; \
      _Pragma("unroll") for (int r = 0; r < 16; ++r) { const int kc = (r & 3) + 8 * (r >> 2); \
        P0[r] = (kc >= klo2_ && kc <= khi2_) ? P0[r] : -INFINITY; P1[r] = (kc + 32 >= klo2_ && kc + 32 <= khi2_) ? P1[r] : -INFINITY; } } \
    float pmax_ = P0[0]; _Pragma("unroll") for (int r = 1; r < 16; ++r) pmax_ = fmaxf(pmax_, P0[r]); _Pragma("unroll") for (int r = 0; r < 16; ++r) pmax_ = fmaxf(pmax_, P1[r]); \
    pmax_ = half_max(pmax_); if (MODE == 2) pmax_ = lsel_ ? pmax_ : -INFINITY;     \
    float mn_ = m_reg; AL = 1.f; \
    if (!__all(pmax_ - m_reg <= 8.f / ATT_SCALE)) { mn_ = fmaxf(m_reg, pmax_); AL = __builtin_amdgcn_exp2f((m_reg - mn_) * C2); m_reg = mn_; }     \
    float mnC_ = -mn_ * C2; if (MODE == 2) mnC_ = lsel_ ? mnC_ : -INFINITY; \
    _Pragma("unroll") for (int r = 0; r < 16; ++r) { P0[r] = fmaf(P0[r], C2, mnC_); P1[r] = fmaf(P1[r], C2, mnC_); } \
    _Pragma("unroll") for (int r = 0; r < 16; ++r) P0[r] = __builtin_amdgcn_exp2f(P0[r]); } while (0)
#define FINISH(P0, P1, AL) do { _Pragma("unroll") for (int r = 0; r < 16; ++r) P1[r] = __builtin_amdgcn_exp2f(P1[r]); \
    float ps_ = 0.f; _Pragma("unroll") for (int r = 0; r < 16; ++r) ps_ += P0[r]; _Pragma("unroll") for (int r = 0; r < 16; ++r) ps_ += P1[r]; \
    ps_ = half_sum(ps_); l_reg = l_reg * AL + ps_; PK4(P0, 0, pa0); PK4(P0, 8, pa1); PK4(P1, 0, pa2); PK4(P1, 8, pa3); } while (0)
#define RESC(AL) do { if (__any((AL) < 1.f)) { if (hi == 0) al_l[r32] = (AL); asm volatile("s_waitcnt lgkmcnt(0)" ::: "memory"); \
    _Pragma("unroll") for (int d = 0; d < 4; ++d) _Pragma("unroll") for (int r = 0; r < 16; ++r) o[d][r] *= al_l[crow(r, hi)]; asm volatile("s_waitcnt lgkmcnt(0)" ::: "memory"); } } while (0)
  f32x16 pA0, pA1, pB0, pB1; float alA = 1.f, alB = 1.f; bf16x8 pa0, pa1, pa2, pa3;
  SLOAD(list[0] & 63); SWRITE(0); __syncthreads();
  SLOAD(list[1] & 63);
  qkt(pA0, pA1, K_lds, qr, r32, hi); { const int j0_ = list[0]; MASK_PART(pA0, pA1, j0_, alA); }
  SWRITE(1);
  __syncthreads();
  for (int i = 1; i + 1 < nt; i += 2) {
    { const int jt = list[i];
      SBAR(); qkt(pB0, pB1, K_lds + SHM_K, qr, r32, hi);
      FINISH(pA0, pA1, alA); SBAR();
      SLOAD(list[i + 1] & 63); SBAR();
      pv_d0(o, vb0, pa0, pa1, pa2, pa3); MASK_PART(pB0, pB1, jt, alB);
      __syncthreads(); SWRITE(0); RESC(alB); __syncthreads(); }
    { const int jt = list[i + 1];
      SBAR(); qkt(pA0, pA1, K_lds, qr, r32, hi);
      FINISH(pB0, pB1, alB); SBAR();
      SLOAD(list[i + 2] & 63); SBAR();
      pv_d0(o, vb0 + SHM_V, pa0, pa1, pa2, pa3); MASK_PART(pA0, pA1, jt, alA);
      __syncthreads(); SWRITE(1); RESC(alA); __syncthreads(); }
  }
  { const int jt = list[nt - 1];
    SBAR(); qkt(pB0, pB1, K_lds + SHM_K, qr, r32, hi);
    FINISH(pA0, pA1, alA); SBAR();
    pv_d0(o, vb0, pa0, pa1, pa2, pa3); MASK_PART(pB0, pB1, jt, alB);
    __syncthreads(); RESC(alB);
    FINISH(pB0, pB1, alB); SBAR();
    pv_d0(o, vb0 + SHM_V, pa0, pa1, pa2, pa3); }
  __syncthreads();
#undef SLOAD
#undef SWRITE
#undef MASK_PART
#undef FINISH
#undef RESC
}
__device__ __forceinline__ void scale_rows(f32x16 (&o)[4], float f, float* wsf, int r32, int hi) {
  if (hi == 0) wsf[r32] = f; asm volatile("s_waitcnt lgkmcnt(0)" ::: "memory");
#pragma unroll
  for (int r = 0; r < 16; ++r) { const float fr = wsf[crow(r, hi)];
#pragma unroll
    for (int d = 0; d < 4; ++d) o[d][r] *= fr; }
  asm volatile("s_waitcnt lgkmcnt(0)" ::: "memory");
}
__device__ __forceinline__ void park_store(const f32x16 (&o)[4], char* lds, int tid) {
#pragma unroll
  for (int k = 0; k < 8; ++k) { const int d = k >> 1, rb = (k & 1) * 8;
    u32x4 w = {cvtpk(o[d][rb], o[d][rb + 1]), cvtpk(o[d][rb + 2], o[d][rb + 3]), cvtpk(o[d][rb + 4], o[d][rb + 5]), cvtpk(o[d][rb + 6], o[d][rb + 7])};
    *(u32x4*)(lds + L_OACC + k * 8192 + tid * 16) = w; }
}
__device__ __forceinline__ void park_add(f32x16 (&o)[4], const char* lds, int tid) {
#pragma unroll
  for (int k = 0; k < 8; ++k) { const int d = k >> 1, rb = (k & 1) * 8; const u32x4 w = *(const u32x4*)(lds + L_OACC + k * 8192 + tid * 16);
    o[d][rb] += __uint_as_float(w.x << 16); o[d][rb + 1] += __uint_as_float(w.x & 0xffff0000u); o[d][rb + 2] += __uint_as_float(w.y << 16); o[d][rb + 3] += __uint_as_float(w.y & 0xffff0000u);
    o[d][rb + 4] += __uint_as_float(w.z << 16); o[d][rb + 5] += __uint_as_float(w.z & 0xffff0000u); o[d][rb + 6] += __uint_as_float(w.w << 16); o[d][rb + 7] += __uint_as_float(w.w & 0xffff0000u); }
}

__device__ __forceinline__ void nsa_unit(unsigned char* ws, unsigned char* Y8, char* lds, const int b, const int g, const int c, const int skip = 0) {
  int tid_ = threadIdx.x; asm volatile("" : "+v"(tid_));
  const int tid = tid_, wid = tid >> 6, lane = tid & 63, r32 = lane & 31, hi = lane >> 5;
  const int t0 = c * 64, tk = wid * 8 + (r32 >> 2), hh = r32 & 3, head = g * 4 + hh;
  const size_t rowq = (size_t)b * SEQ + t0 + tk;
  bf16_t* QY = (bf16_t*)(ws + WS_QY); const bf16_t* KVb = (const bf16_t*)(ws + WS_KV) + (size_t)b * SEQ * 3072 + g * 128;
  const bf16_t* KC = (const bf16_t*)(ws + WS_KC) + (size_t)(b * 4 + g) * 256 * 128; const bf16_t* VC = (const bf16_t*)(ws + WS_VC) + (size_t)(b * 4 + g) * 256 * 128;
  float* wsf = (float*)(lds + L_WSF) + wid * 64;
  float* impG = (float*)(lds + L_IMPG); float* impE = (float*)(lds + L_IMPE); float* impF = (float*)(lds + L_IMPF);
  unsigned* selm = (unsigned*)(lds + L_SEL); int* lists = (int*)(lds + L_LIST);
  bf16x8 qr[8];
  { const bf16_t* Qw = QY + rowq * 2048 + head * 128 + hi * 8;
#pragma unroll
    for (int d0 = 0; d0 < 8; ++d0) qr[d0] = *(const bf16x8*)(Qw + d0 * 16); }
  float* gl = (float*)(lds + L_GATE) + wid * 96;
  if (hi == 0) { const float* gp = (const float*)(ws + WS_SMB) + rowq * 64 + head * 3; constexpr size_t SLAB = (size_t)T * 64;
#pragma unroll
    for (int k = 0; k < 3; ++k) gl[32 * k + r32] = sigm(((gp[k] + gp[SLAB + k]) + gp[2 * SLAB + k]) + gp[3 * SLAB + k]); }
#define GATE(k) gl[32 * (k) + r32]
  const int nvalid = (4 * c + 3 > 255) ? 255 : 4 * c + 3; const int ntc = (nvalid + 63) >> 6;
  if (tid < 4) lists[tid] = tid;
  __syncthreads();
  f32x16 o[4]; o[0] = f32x16{}; o[1] = f32x16{}; o[2] = f32x16{}; o[3] = f32x16{};
  float m_reg = -1e30f, l_reg = 0.f;
  if (!((skip >> 9) & 1)) run_branch<0>(lds, KC, VC, 128, lists, ntc, qr, o, m_reg, l_reg, c, tk, t0, 0u, 0u, 0.f, 0.f);
  if (!((skip >> 9) & 1)) { const float inv_l = l_reg > 0.f ? 1.f / l_reg : 0.f;
    const float g0 = GATE(0);
    run_branch<1>(lds, KC, VC, 128, lists, ntc, qr, o, m_reg, l_reg, c, tk, t0, 0u, 0u, inv_l, g0); }
  { const int stk = tid >> 3, part = tid & 7;
#pragma unroll
    for (int jj = 0; jj < 8; ++jj) { const int j = part * 8 + jj; float v = impG[stk * 64 + j] + (j > 0 ? impE[stk * 64 + j - 1] : 0.f);
      const bool forced = (j == 0) || (j == c) || (j == c - 1); v = forced ? 1e9f : (j > c ? -1e9f : v); impF[stk * 64 + j] = v; }
    __syncthreads();
    unsigned mybits = 0;
#pragma unroll
    for (int jj = 0; jj < 8; ++jj) { const int j = part * 8 + jj; const float v = impF[stk * 64 + j]; int rank = 0;
      for (int i = 0; i < 64; ++i) { const float u = impF[stk * 64 + i]; rank += (u > v || (u == v && i < j)) ? 1 : 0; }
      if (rank < 16) mybits |= 1u << jj; }
    unsigned lo = 0, hi_ = 0;
#pragma unroll
    for (int pp = 0; pp < 8; ++pp) { const unsigned bb = __shfl(mybits, (lane & ~7) + pp); if (pp < 4) lo |= bb << (8 * pp); else hi_ |= bb << (8 * (pp - 4)); }
    if (part == 0) { selm[stk * 2] = lo; selm[stk * 2 + 1] = hi_; }
    __syncthreads();
    if (wid == 0) { unsigned ulo = selm[lane * 2], uhi = selm[lane * 2 + 1];
#pragma unroll
      for (int off = 32; off >= 1; off >>= 1) { ulo |= __shfl_xor(ulo, off); uhi |= __shfl_xor(uhi, off); }
      if (lane == 0) { int n = 0; for (int j = 0; j <= c; ++j) { const unsigned bit = (j < 32) ? ((ulo >> j) & 1u) : ((uhi >> (j - 32)) & 1u); if (bit) lists[4 + n++] = j; }
        if (n & 1) { lists[4 + n] = lists[4 + n - 1] | 64; ++n; } lists[84] = n;
        int n2 = 0; for (int j = (c > 8 ? c - 8 : 0); j <= c; ++j) lists[68 + n2++] = j;
        if (n2 & 1) { lists[68 + n2] = lists[68 + n2 - 1] | 64; ++n2; } lists[85] = n2; } }
    __syncthreads();
  }
  const unsigned sel_lo = selm[tk * 2], sel_hi = selm[tk * 2 + 1];
  const int n_slc = lists[84], n_win = lists[85];
  park_store(o, lds, tid);
  o[0] = f32x16{}; o[1] = f32x16{}; o[2] = f32x16{}; o[3] = f32x16{}; m_reg = -1e30f; l_reg = 0.f;
  if (!((skip >> 11) & 1)) run_branch_pipe<2>(lds, KVb + 1024, KVb + 1536, 3072, lists + 4, n_slc, qr, o, m_reg, l_reg, c, tk, sel_lo, sel_hi);
  { const float g1 = GATE(1); scale_rows(o, l_reg > 0.f ? g1 / l_reg : 0.f, wsf, r32, hi); }
  park_add(o, lds, tid); park_store(o, lds, tid);
  o[0] = f32x16{}; o[1] = f32x16{}; o[2] = f32x16{}; o[3] = f32x16{}; m_reg = -1e30f; l_reg = 0.f;
  if (!((skip >> 12) & 1)) run_branch_pipe<3>(lds, KVb + 2048, KVb + 2560, 3072, lists + 68, n_win, qr, o, m_reg, l_reg, c, tk, 0u, 0u);
  { const float g2 = GATE(2); scale_rows(o, l_reg > 0.f ? g2 / l_reg : 0.f, wsf, r32, hi); }
#undef GATE
  park_add(o, lds, tid);
  __syncthreads();
  { int ln_ = lane; asm volatile("" : "+v"(ln_));
    bf16_t* yt = (bf16_t*)(lds + L_OACC) + wid * (32 * 136);
#pragma unroll
    for (int r = 0; r < 16; ++r) { const int row = crow(r, hi);
#pragma unroll
      for (int d0 = 0; d0 < 4; ++d0) yt[row * 136 + d0 * 32 + r32] = f2bf(o[d0][r]); }
    asm volatile("s_waitcnt lgkmcnt(0)" ::: "memory");
#pragma unroll
    for (int k = 0; k < 8; ++k) { const int id = ln_ + 64 * k, row = id >> 4, ch = id & 15; const int tkr = wid * 8 + (row >> 2), hr = row & 3;
      *(unsigned long long*)(Y8 + ((size_t)b * SEQ + t0 + tkr) * 3072 + 1024 + (g * 4 + hr) * 128 + 8 * ch) = pg8::bf8_to_f8(*(const pg8::bf16x8*)(yt + row * 136 + 8 * ch), 8.f); } }
  __syncthreads();
}
#undef PK4
#undef KSWZ
#undef SBAR
}

namespace cmpu {
using bf16x8 = __attribute__((ext_vector_type(8))) short;
using f32x4  = __attribute__((ext_vector_type(4))) float;
constexpr int NTOK = 528, HID_PITCH = 136, L_TOK = 0, L_HID = NTOK * 256;
static_assert(L_HID + 32 * HID_PITCH * 2 <= 147456 - 64, "compress LDS map");
__device__ __forceinline__ void cmp_unit(unsigned char* ws, char* lds, const int which, const int bg, const int nb2) {
  int tid_ = threadIdx.x; asm volatile("" : "+v"(tid_));
  const int tid = tid_, lane = tid & 63, i = lane & 15, gq = lane >> 4; const int w = __builtin_amdgcn_readfirstlane(tid >> 6);
  const int b = bg >> 2, g = bg & 3;
  bf16_t* hid = (bf16_t*)(lds + L_HID);
  const bf16_t* KV = (const bf16_t*)(ws + WS_KV); const float* tab = (const float*)(ws + WS_ROPE);
  for (int ch = tid; ch < NTOK * 16; ch += 512) { const int tl = ch >> 4, cx = ch & 15, c8 = cx * 8; const int tg = 512 * nb2 + tl;
    bf16x8 v = bf16x8{};
    if (tg < SEQ) { const size_t trow = (size_t)b * SEQ + tg; const bf16_t* src = KV + trow * 3072 + which * 512 + g * 128;
      v = *(const bf16x8*)(src + c8);
      if (which == 0 && c8 < 32) { const bf16x8 vp = *(const bf16x8*)(src + (c8 ^ 16)); const float* tb = tab + (trow * 16 + (c8 & 15)) * 2;
#pragma unroll
        for (int e = 0; e < 8; ++e) { const float cs = tb[2 * e], sn = tb[2 * e + 1]; const float a = bf2f((bf16_t)v[e]), p = bf2f((bf16_t)vp[e]);
          const float r = (c8 < 16) ? (a * cs - p * sn) : (a * cs + p * sn); v[e] = (short)f2bf(r); } } }
    const int slot = (tl & 15) * 33 + (tl >> 4);
    *(bf16x8*)(lds + L_TOK + slot * 256 + ((cx ^ (slot & 7)) << 4)) = v; }
  __syncthreads();
  const bf16_t* W1T = (const bf16_t*)(ws + WS_W1T + (which ? MiB : 0)); const bf16_t* W2T = (const bf16_t*)(ws + WS_SMALL + (which ? 128 : 64) * 1024);
  const float* bias = (const float*)(ws + WS_SMALL) + which * 128;
  const bf16_t* Bp = W1T + (size_t)(16 * w + i) * 4096 + 8 * gq;
  f32x4 acc0 = {0.f, 0.f, 0.f, 0.f}, acc1 = {0.f, 0.f, 0.f, 0.f};
#pragma unroll 4
  for (int l = 0; l < 32; ++l) { const int s0 = (l & 15) * 33 + i + (l >> 4), s1 = s0 + 16;
#pragma unroll
    for (int ks = 0; ks < 4; ++ks) { const int cx = 4 * ks + gq;
      const bf16x8 a0 = *(const bf16x8*)(lds + L_TOK + s0 * 256 + ((cx ^ (s0 & 7)) << 4)), a1 = *(const bf16x8*)(lds + L_TOK + s1 * 256 + ((cx ^ (s1 & 7)) << 4));
      const bf16x8 bv = *(const bf16x8*)(Bp + l * 128 + 32 * ks);
      acc0 = __builtin_amdgcn_mfma_f32_16x16x32_bf16(a0, bv, acc0, 0, 0, 0); acc1 = __builtin_amdgcn_mfma_f32_16x16x32_bf16(a1, bv, acc1, 0, 0, 0); } }
  { const float bs = bias[16 * w + i];
#pragma unroll
    for (int r = 0; r < 4; ++r) { hid[(4 * gq + r) * HID_PITCH + 16 * w + i] = f2bf(gelu_tanh(acc0[r] + bs)); hid[(16 + 4 * gq + r) * HID_PITCH + 16 * w + i] = f2bf(gelu_tanh(acc1[r] + bs)); } }
  __syncthreads();
  f32x4 o0 = {0.f, 0.f, 0.f, 0.f}, o1 = {0.f, 0.f, 0.f, 0.f};
#pragma unroll
  for (int ks = 0; ks < 4; ++ks) { const bf16x8 bv = *(const bf16x8*)(W2T + (16 * w + i) * 128 + 32 * ks + 8 * gq);
    const bf16x8 a0 = *(const bf16x8*)(hid + i * HID_PITCH + 32 * ks + 8 * gq), a1 = *(const bf16x8*)(hid + (16 + i) * HID_PITCH + 32 * ks + 8 * gq);
    o0 = __builtin_amdgcn_mfma_f32_16x16x32_bf16(a0, bv, o0, 0, 0, 0); o1 = __builtin_amdgcn_mfma_f32_16x16x32_bf16(a1, bv, o1, 0, 0, 0); }
  bf16_t* outp = (bf16_t*)(ws + (which ? WS_VC : WS_KC)) + (size_t)bg * 256 * 128;
#pragma unroll
  for (int r = 0; r < 4; ++r) { const int n0 = 32 * nb2 + 4 * gq + r, n1 = n0 + 16;
    outp[(size_t)n0 * 128 + 16 * w + i] = f2bf(o0[r]); outp[(size_t)n1 * 128 + 16 * w + i] = (n1 == 255) ? (bf16_t)0 : f2bf(o1[r]); }
  __syncthreads();
}
}


namespace peer {
using bf16x8 = __attribute__((ext_vector_type(8))) short;
using f32x4  = __attribute__((ext_vector_type(4))) float;
typedef unsigned u32x4 __attribute__((ext_vector_type(4)));
typedef __bf16 bf16x2_t __attribute__((ext_vector_type(2)));
constexpr int L_PE = 0, L_PW = 32768, L_H2S = 65536, L_RS = L_H2S + 32768, L_END = L_RS + 256;
constexpr int NSLICE = 16;
__device__ __forceinline__ int sortable(float f) { const int u = __float_as_int(f); return u ^ ((u >> 31) & 0x7fffffff); }
__device__ __forceinline__ float unsortable(int k) { return __int_as_float(k ^ ((k >> 31) & 0x7fffffff)); }
__device__ __forceinline__ float dot2(unsigned a, unsigned b, float c) { return __builtin_amdgcn_fdot2_f32_bf16(__builtin_bit_cast(bf16x2_t, a), __builtin_bit_cast(bf16x2_t, b), c, false); }
__device__ __forceinline__ float bflo(unsigned w) { return __uint_as_float(w << 16); }
__device__ __forceinline__ float bfhi(unsigned w) { return __uint_as_float(w & 0xffff0000u); }
__device__ __forceinline__ void topk_half(const float* __restrict__ qtile, const float* __restrict__ sk, float* kbuf, const int lane, int (&list)[16]) {
  const int i = lane & 15, gq = lane >> 4;
  float bq[4][16];
#pragma unroll
  for (int tt = 0; tt < 4; ++tt) { const float* qp_ = qtile + (size_t)(16 * tt + i) * 1024 + 16 * gq;
#pragma unroll
    for (int u = 0; u < 4; ++u) { const f32x4 v = *(const f32x4*)(qp_ + 4 * u); bq[tt][4 * u] = v[0]; bq[tt][4 * u + 1] = v[1]; bq[tt][4 * u + 2] = v[2]; bq[tt][4 * u + 3] = v[3]; } }
#pragma unroll
  for (int k = 0; k < 16; ++k) list[k] = (int)0x80000000;
  float an[16];
  { const float* sp = sk + (size_t)i * 64 + 16 * gq;
#pragma unroll
    for (int u = 0; u < 4; ++u) { const f32x4 v = *(const f32x4*)(sp + 4 * u); an[4 * u] = v[0]; an[4 * u + 1] = v[1]; an[4 * u + 2] = v[2]; an[4 * u + 3] = v[3]; } }
#pragma unroll 1
  for (int nt = 0; nt < 8; ++nt) {
    float ak[16];
#pragma unroll
    for (int u = 0; u < 16; ++u) ak[u] = an[u];
    if (nt < 7) { const float* sp = sk + (size_t)(16 * (nt + 1) + i) * 64 + 16 * gq;
#pragma unroll
      for (int u = 0; u < 4; ++u) { const f32x4 v = *(const f32x4*)(sp + 4 * u); an[4 * u] = v[0]; an[4 * u + 1] = v[1]; an[4 * u + 2] = v[2]; an[4 * u + 3] = v[3]; } }
    f32x4 cacc[4];
#pragma unroll
    for (int tt = 0; tt < 4; ++tt) cacc[tt] = (f32x4){0.f, 0.f, 0.f, 0.f};
#pragma unroll
    for (int ks = 0; ks < 16; ++ks)
#pragma unroll
      for (int tt = 0; tt < 4; ++tt) cacc[tt] = __builtin_amdgcn_mfma_f32_16x16x4f32(ak[ks], bq[tt][ks], cacc[tt], 0, 0, 0);
#pragma unroll
    for (int tt = 0; tt < 4; ++tt)
#pragma unroll
      for (int r = 0; r < 4; ++r) kbuf[(4 * gq + r) * 64 + 16 * tt + i] = cacc[tt][r];
    asm volatile("s_waitcnt lgkmcnt(0)" ::: "memory");
    float sc[16];
#pragma unroll
    for (int nn = 0; nn < 16; ++nn) sc[nn] = kbuf[nn * 64 + lane];
    asm volatile("s_waitcnt lgkmcnt(0)" ::: "memory");
    int cn[16];
#pragma unroll
    for (int nn = 0; nn < 16; ++nn) cn[nn] = (sortable(sc[nn]) & ~127) | (127 - (nt * 16 + nn));
#pragma unroll
    for (int k = 2; k <= 16; k <<= 1)
#pragma unroll
      for (int j = k >> 1; j > 0; j >>= 1)
#pragma unroll
        for (int i2 = 0; i2 < 16; ++i2) { const int l = i2 ^ j; if (l > i2) { const int a_ = cn[i2], b_ = cn[l]; if ((i2 & k) == 0) { cn[i2] = max(a_, b_); cn[l] = min(a_, b_); } else { cn[i2] = min(a_, b_); cn[l] = max(a_, b_); } } }
#pragma unroll
    for (int k = 0; k < 16; ++k) list[k] = max(list[k], cn[15 - k]);
#pragma unroll
    for (int j = 8; j > 0; j >>= 1)
#pragma unroll
      for (int i2 = 0; i2 < 16; ++i2) { const int l = i2 ^ j; if (l > i2) { const int a_ = list[i2], b_ = list[l]; list[i2] = max(a_, b_); list[l] = min(a_, b_); } }
  }
}
__device__ __forceinline__ void route_tile(unsigned char* ws, char* lds, const float* __restrict__ sk1, const float* __restrict__ sk2, const int tile) {
  int tid_ = threadIdx.x; asm volatile("" : "+v"(tid_));
  const int lane = tid_ & 63; const int h = __builtin_amdgcn_readfirstlane(tid_ >> 6);
  const size_t t = (size_t)tile * 64 + lane;
  const float* qtile = (const float*)(ws + WS_QP) + (size_t)tile * 64 * 1024 + h * 128;
  int l1[16], l2[16];
  float* kbuf = (float*)(lds + L_H2S) + h * 1024;
  topk_half(qtile, sk1 + (size_t)h * 128 * 64, kbuf, lane, l1);
  topk_half(qtile + 64, sk2 + (size_t)h * 128 * 64, kbuf, lane, l2);
  float vv[16]; int pp[16];
#pragma unroll
  for (int k = 0; k < 16; ++k) { vv[k] = -INFINITY; pp[k] = 0; }
#pragma unroll
  for (int a = 0; a < 16; ++a)
#pragma unroll
    for (int b = 0; b < 16; ++b) if ((a + 1) * (b + 1) <= 16) {
      float x = unsortable(l1[a] & ~127) + unsortable(l2[b] & ~127); int px = ((127 - (l1[a] & 127)) << 7) | (127 - (l2[b] & 127));
#pragma unroll
      for (int k = 0; k < 16; ++k) { const bool gt = x > vv[k]; const float nv = gt ? x : vv[k]; x = gt ? vv[k] : x; vv[k] = nv; const int np = gt ? px : pp[k]; px = gt ? pp[k] : px; pp[k] = np; } }
  const float vmax = vv[0]; float sum = 0.f;
#pragma unroll
  for (int k = 0; k < 16; ++k) { vv[k] = __expf(vv[k] - vmax); sum += vv[k]; }
  const float inv = 1.f / sum;
  int* pe = (int*)(lds + L_PE) + lane * 128 + h * 16; float* pg = (float*)(lds + L_PW) + lane * 128 + h * 16;
#pragma unroll
  for (int k = 0; k < 16; ++k) { pe[k] = pp[k]; pg[k] = vv[k] * inv; }
  if (h == 0) { const float* sp = (const float*)(ws + WS_W1T) + t * 32; float sq = 0.f;
#pragma unroll
    for (int k = 0; k < 8; ++k) { const f32x4 v = *(const f32x4*)(sp + 4 * k); sq += (v[0] + v[1]) + (v[2] + v[3]); }
    ((float*)(lds + L_RS))[lane] = rsqrtf(sq * (1.f / 2048.f) + EPS); }
}
typedef float f32x2_t __attribute__((ext_vector_type(2)));
#define FP8LO(wd) __builtin_amdgcn_cvt_pk_f32_fp8((int)(wd), false)
#define FP8HI(wd) __builtin_amdgcn_cvt_pk_f32_fp8((int)(wd), true)
__device__ __forceinline__ void up_pass(unsigned char* ws, char* lds, const float* __restrict__ g2, const int tile) {
  int tid_ = threadIdx.x; asm volatile("" : "+v"(tid_));
  const int tid = tid_, lane = tid & 63, g = lane >> 3, cc = lane & 7; const int w = __builtin_amdgcn_readfirstlane(tid >> 6);
  const int* PE = (const int*)(lds + L_PE) + (w * 8 + g) * 128; float* PW = (float*)(lds + L_PW) + (w * 8 + g) * 128; bf16_t* H2S = (bf16_t*)(lds + L_H2S);
  const bf16_t* XB = (const bf16_t*)(ws + WS_XB) + ((size_t)tile * 64 + (tid >> 4)) * 2048 + 8 * (tid & 15);
  float acc[128];
#pragma unroll
  for (int j = 0; j < 128; ++j) acc[j] = 0.f;
#define STAGE_H2(sig, buf) do { _Pragma("unroll") for (int hh_ = 0; hh_ < 2; ++hh_) { const u32x4 xv = *(const u32x4*)(XB + (size_t)hh_ * 32 * 2048 + 128 * (sig)); \
    const f32x4 ga = *(const f32x4*)(g2 + 128 * (sig) + 8 * (tid & 15)), gb = *(const f32x4*)(g2 + 128 * (sig) + 8 * (tid & 15) + 4); \
    u32x4 hv; hv.x = att::cvtpk(bflo(xv.x) * ga[0], bfhi(xv.x) * ga[1]); hv.y = att::cvtpk(bflo(xv.y) * ga[2], bfhi(xv.y) * ga[3]); hv.z = att::cvtpk(bflo(xv.z) * gb[0], bfhi(xv.z) * gb[1]); hv.w = att::cvtpk(bflo(xv.w) * gb[2], bfhi(xv.w) * gb[3]); \
    *(u32x4*)(H2S + (buf) * 8192 + ((tid >> 4) + 32 * hh_) * 128 + 8 * (tid & 15)) = hv; } } while (0)
  __syncthreads();
  STAGE_H2(0, 0);
  __syncthreads();
#define UP_LOAD(jb, B) do { _Pragma("unroll") for (int i_ = 0; i_ < 8; ++i_) { const unsigned e_ = (unsigned)PE[8 * (jb) + i_]; B[i_] = *(const u32x4*)(Us + ((e_ << 7) + lo16)); } } while (0)
#define UP_COMP(jb, B) do { _Pragma("unroll") for (int i_ = 0; i_ < 8; ++i_) { const u32x4 u_ = B[i_]; f32x2_t t_ = hp[0] * FP8LO(u_.x); t_ = hp[1] * FP8HI(u_.x) + t_; t_ = hp[2] * FP8LO(u_.y) + t_; t_ = hp[3] * FP8HI(u_.y) + t_; \
      t_ = hp[4] * FP8LO(u_.z) + t_; t_ = hp[5] * FP8HI(u_.z) + t_; t_ = hp[6] * FP8LO(u_.w) + t_; t_ = hp[7] * FP8HI(u_.w) + t_; acc[8 * (jb) + i_] += t_[0] + t_[1]; } } while (0)
  const unsigned lo16 = 16u * (unsigned)cc;
#pragma unroll 1
  for (int sig = 0; sig < NSLICE; ++sig) {
    const int buf = sig & 1;
    if (sig + 1 < NSLICE) STAGE_H2(sig + 1, buf ^ 1);
    const unsigned char* Us = ws + WS_UB + (size_t)sig * 16384 * 128;
    u32x4 bA[8], bB[8];
    UP_LOAD(0, bA); UP_LOAD(1, bB);
    const u32x4 ha = *(const u32x4*)(H2S + buf * 8192 + (w * 8 + g) * 128 + 16 * cc), hb = *(const u32x4*)(H2S + buf * 8192 + (w * 8 + g) * 128 + 16 * cc + 8);
    f32x2_t hp[8]; hp[0] = (f32x2_t){bflo(ha.x), bfhi(ha.x)}; hp[1] = (f32x2_t){bflo(ha.y), bfhi(ha.y)}; hp[2] = (f32x2_t){bflo(ha.z), bfhi(ha.z)}; hp[3] = (f32x2_t){bflo(ha.w), bfhi(ha.w)};
    hp[4] = (f32x2_t){bflo(hb.x), bfhi(hb.x)}; hp[5] = (f32x2_t){bflo(hb.y), bfhi(hb.y)}; hp[6] = (f32x2_t){bflo(hb.z), bfhi(hb.z)}; hp[7] = (f32x2_t){bflo(hb.w), bfhi(hb.w)};
#pragma unroll
    for (int jp = 0; jp < 8; ++jp) {
      __builtin_amdgcn_sched_barrier(0);
      UP_COMP(2 * jp, bA);
      __builtin_amdgcn_sched_barrier(0);
      if (jp < 7) UP_LOAD(2 * jp + 2, bA);
      __builtin_amdgcn_sched_barrier(0);
      UP_COMP(2 * jp + 1, bB);
      __builtin_amdgcn_sched_barrier(0);
      if (jp < 7) UP_LOAD(2 * jp + 3, bB);
      __builtin_amdgcn_sched_barrier(0); }
    __syncthreads();
  }
#undef UP_LOAD
#undef UP_COMP
#undef STAGE_H2
  const float rs = ((const float*)(lds + L_RS))[w * 8 + g]; const float* SU = (const float*)(ws + WS_UB + 64 * MiB); const float* SV = SU + 16384;
  { const bool b4 = (cc & 4) != 0, b2 = (cc & 2) != 0, b1 = (cc & 1) != 0;
    float r4[64];
#pragma unroll
    for (int k = 0; k < 16; ++k)
#pragma unroll
      for (int t = 0; t < 4; ++t) { const float lo = acc[8 * k + t], hi = acc[8 * k + t + 4]; r4[4 * k + t] = (b4 ? hi : lo) + __shfl_xor(b4 ? lo : hi, 4); }
    float r2[32];
#pragma unroll
    for (int k = 0; k < 16; ++k)
#pragma unroll
      for (int t = 0; t < 2; ++t) { const float lo = r4[4 * k + t], hi = r4[4 * k + t + 2]; r2[2 * k + t] = (b2 ? hi : lo) + __shfl_xor(b2 ? lo : hi, 2); }
    float r1[16];
#pragma unroll
    for (int k = 0; k < 16; ++k) { const float lo = r2[2 * k], hi = r2[2 * k + 1]; r1[k] = (b1 ? hi : lo) + __shfl_xor(b1 ? lo : hi, 1); }
    int ex[16]; float su[16], sv[16], pw[16];
#pragma unroll
    for (int k = 0; k < 16; ++k) { ex[k] = PE[8 * k + cc]; pw[k] = PW[8 * k + cc]; }
#pragma unroll
    for (int k = 0; k < 16; ++k) { su[k] = SU[ex[k]]; sv[k] = SV[ex[k]]; }
#pragma unroll
    for (int k = 0; k < 16; ++k) { const float x = r1[k] * rs * su[k]; const float u = 1.5957691216057308f * (x + 0.044715f * x * x * x);
      PW[8 * k + cc] = pw[k] * (x * __builtin_amdgcn_rcpf(1.f + __expf(-u))) * sv[k]; } }
  __syncthreads();
}
__device__ __forceinline__ void down_pass(unsigned char* ws, char* lds, float* __restrict__ out, const float* __restrict__ fg, const int tile) {
  int tid_ = threadIdx.x; asm volatile("" : "+v"(tid_));
  const int tid = tid_, lane = tid & 63, g = lane >> 3, cc = lane & 7; const int w = __builtin_amdgcn_readfirstlane(tid >> 6);
  const int* PE = (const int*)(lds + L_PE) + (w * 8 + g) * 128; const float* PW = (const float*)(lds + L_PW) + (w * 8 + g) * 128;
  float* orow = out + ((size_t)tile * 64 + w * 8 + g) * 2048 + 16 * cc; const bf16_t* xrow = (const bf16_t*)(ws + WS_XB) + ((size_t)tile * 64 + w * 8 + g) * 2048 + 16 * cc;
  float ss = 0.f;
#define DN_LOAD(jb, B) do { _Pragma("unroll") for (int i_ = 0; i_ < 16; ++i_) { const unsigned e_ = (unsigned)PE[16 * (jb) + i_]; B[i_] = *(const u32x4*)(Vs + ((e_ << 7) + lo16)); } } while (0)
#define DN_COMP(jb, B) do { _Pragma("unroll") for (int i_ = 0; i_ < 16; ++i_) { const float wj_ = PW[16 * (jb) + i_]; const f32x2_t w2_ = {wj_, wj_}; const u32x4 v_ = B[i_]; \
      ap[0] = w2_ * FP8LO(v_.x) + ap[0]; ap[1] = w2_ * FP8HI(v_.x) + ap[1]; ap[2] = w2_ * FP8LO(v_.y) + ap[2]; ap[3] = w2_ * FP8HI(v_.y) + ap[3]; \
      ap[4] = w2_ * FP8LO(v_.z) + ap[4]; ap[5] = w2_ * FP8HI(v_.z) + ap[5]; ap[6] = w2_ * FP8LO(v_.w) + ap[6]; ap[7] = w2_ * FP8HI(v_.w) + ap[7]; } } while (0)
  const unsigned lo16 = 16u * (unsigned)cc;
#pragma unroll 1
  for (int sig = 0; sig < NSLICE; ++sig) {
    const unsigned char* Vs = ws + WS_UB + 32 * MiB + (size_t)sig * 16384 * 128;
    u32x4 bA[16], bB[16];
    DN_LOAD(0, bA); DN_LOAD(1, bB);
    float* p = orow + 128 * sig;
    const u32x4 ra = *(const u32x4*)(xrow + 128 * sig), rb = *(const u32x4*)(xrow + 128 * sig + 8);
    f32x4 x0 = {bflo(ra.x), bfhi(ra.x), bflo(ra.y), bfhi(ra.y)}, x1 = {bflo(ra.z), bfhi(ra.z), bflo(ra.w), bfhi(ra.w)}, x2 = {bflo(rb.x), bfhi(rb.x), bflo(rb.y), bfhi(rb.y)}, x3 = {bflo(rb.z), bfhi(rb.z), bflo(rb.w), bfhi(rb.w)};
    f32x2_t ap[8];
#pragma unroll
    for (int k = 0; k < 8; ++k) ap[k] = (f32x2_t){0.f, 0.f};
#pragma unroll
    for (int jp = 0; jp < 4; ++jp) {
      __builtin_amdgcn_sched_barrier(0);
      DN_COMP(2 * jp, bA);
      __builtin_amdgcn_sched_barrier(0);
      if (jp < 3) DN_LOAD(2 * jp + 2, bA);
      __builtin_amdgcn_sched_barrier(0);
      DN_COMP(2 * jp + 1, bB);
      __builtin_amdgcn_sched_barrier(0);
      if (jp < 3) DN_LOAD(2 * jp + 3, bB);
      __builtin_amdgcn_sched_barrier(0); }
    x0[0] += ap[0][0]; x0[1] += ap[0][1]; x0[2] += ap[1][0]; x0[3] += ap[1][1]; x1[0] += ap[2][0]; x1[1] += ap[2][1]; x1[2] += ap[3][0]; x1[3] += ap[3][1];
    x2[0] += ap[4][0]; x2[1] += ap[4][1]; x2[2] += ap[5][0]; x2[3] += ap[5][1]; x3[0] += ap[6][0]; x3[1] += ap[6][1]; x3[2] += ap[7][0]; x3[3] += ap[7][1];
    *(f32x4*)p = x0; *(f32x4*)(p + 4) = x1; *(f32x4*)(p + 8) = x2; *(f32x4*)(p + 12) = x3;
    ss += ((x0[0] * x0[0] + x0[1] * x0[1]) + (x0[2] * x0[2] + x0[3] * x0[3])) + ((x1[0] * x1[0] + x1[1] * x1[1]) + (x1[2] * x1[2] + x1[3] * x1[3]))
        + ((x2[0] * x2[0] + x2[1] * x2[1]) + (x2[2] * x2[2] + x2[3] * x2[3])) + ((x3[0] * x3[0] + x3[1] * x3[1]) + (x3[2] * x3[2] + x3[3] * x3[3]));
  }
#undef DN_LOAD
#undef DN_COMP
  ss += __shfl_xor(ss, 1); ss += __shfl_xor(ss, 2); ss += __shfl_xor(ss, 4);
  const float rsl = rsqrtf(ss * (1.f / 2048.f) + EPS);
  float rsv[8];
#pragma unroll
  for (int tt = 0; tt < 8; ++tt) rsv[tt] = __shfl(rsl, tt * 8);
  asm volatile("s_waitcnt vmcnt(0)" ::: "memory");
  __builtin_amdgcn_fence(__ATOMIC_ACQUIRE, "agent");
  asm volatile("s_waitcnt vmcnt(0)" ::: "memory");
  float* obase = out + ((size_t)tile * 64 + w * 8) * 2048 + 4 * lane;
#pragma unroll
  for (int tt = 0; tt < 8; ++tt) {
#pragma unroll
    for (int q = 0; q < 8; ++q) { float* pp = obase + (size_t)tt * 2048 + 256 * q; const f32x4 x = *(const f32x4*)pp, f = *(const f32x4*)(fg + 4 * lane + 256 * q);
      f32x4 o; o[0] = x[0] * rsv[tt] * f[0]; o[1] = x[1] * rsv[tt] * f[1]; o[2] = x[2] * rsv[tt] * f[2]; o[3] = x[3] * rsv[tt] * f[3]; *(f32x4*)pp = o; }
    __builtin_amdgcn_sched_barrier(0); }
}
#undef FP8LO
#undef FP8HI
}


namespace gla {
using bf16x8 = __attribute__((ext_vector_type(8))) short;
using s16x4  = __attribute__((ext_vector_type(4))) short;
using f32x4  = __attribute__((ext_vector_type(4))) float;
constexpr int P_QK = 136, P_T = 72, P_LA = 129;
constexpr int L_QB = 0, L_KB = L_QB + 64 * P_QK * 2, L_KLT = L_KB + 64 * P_QK * 2, L_VT = L_KLT + 128 * P_T * 2, L_ATT = L_VT + 256 * P_T * 2, L_LA = L_ATT + 64 * P_T * 2, L_END = L_LA + 64 * P_LA * 4;
static_assert(L_END <= 147456 - 1024, "GLA LDS map");
constexpr size_t WS_ADEC = WS_SMALL + 512 * 1024;
__device__ __forceinline__ void passA(unsigned char* ws, char* lds, const float* __restrict__ wdecay, const float* __restrict__ bdecay, const int bh, const int c) {
  int tid_ = threadIdx.x; asm volatile("" : "+v"(tid_));
  const int tid = tid_, lane = tid & 63; const int cg = __builtin_amdgcn_readfirstlane(tid >> 6);
  const int b = bh >> 2, h = bh & 3; const int srow = lane; const size_t tok = (size_t)b * SEQ + 64 * c + srow;
  bf16_t* QB = (bf16_t*)(lds + L_QB); bf16_t* KB = (bf16_t*)(lds + L_KB); bf16_t* KLT = (bf16_t*)(lds + L_KLT); bf16_t* VT = (bf16_t*)(lds + L_VT); bf16_t* ATT = (bf16_t*)(lds + L_ATT); float* LA = (float*)(lds + L_LA);
  bf16_t* GQK = (bf16_t*)(ws + WS_GQK); bf16_t* GV = (bf16_t*)(ws + WS_GV);
  bf16x8 q8s[2], k8s[2], v8s[4];
#pragma unroll
  for (int i2 = 0; i2 < 2; ++i2) { const int ch = 2 * cg + i2; q8s[i2] = *(const bf16x8*)(GQK + tok * 1024 + h * 128 + 8 * ch); k8s[i2] = *(const bf16x8*)(GQK + tok * 1024 + 512 + h * 128 + 8 * ch); }
#pragma unroll
  for (int i4 = 0; i4 < 4; ++i4) v8s[i4] = *(const bf16x8*)(GV + tok * 1024 + h * 256 + 8 * (4 * cg + i4));
  float bc[16], bl[16];
  { float* GLs = (float*)(lds + L_LA); const int row = tid >> 3, u4 = tid & 3, sp2 = (tid >> 2) & 1; constexpr size_t SLAB = (size_t)T * 64;
    const float* sp0 = (const float*)(ws + WS_SMB) + ((size_t)b * SEQ + 64 * c + row) * 64 + 48 + 4 * u4 + (size_t)(2 * sp2) * SLAB;
    *(f32x4*)(GLs + row * 36 + sp2 * 16 + 4 * u4) = *(const f32x4*)sp0 + *(const f32x4*)(sp0 + SLAB); }
  const f32x4 wq = *(const f32x4*)(wdecay + (lane >> 2) * 512 + h * 128 + cg * 16 + 4 * (lane & 3));
  const float bq = bdecay[h * 128 + cg * 16 + (lane & 15)];
  __syncthreads();
#define RLF(x, l) __int_as_float(__builtin_amdgcn_readlane(__float_as_int(x), (l)))
  { float gl[16];
#pragma unroll
    for (int u = 0; u < 4; ++u) { const float* gp = (const float*)(lds + L_LA) + srow * 36 + 4 * u; const f32x4 v = *(const f32x4*)gp + *(const f32x4*)(gp + 16);
      gl[4 * u] = v[0]; gl[4 * u + 1] = v[1]; gl[4 * u + 2] = v[2]; gl[4 * u + 3] = v[3]; }
#pragma unroll
    for (int dd = 0; dd < 16; ++dd) { float z = RLF(bq, dd);
#pragma unroll
      for (int rr = 0; rr < 16; ++rr) z = fmaf(gl[rr], RLF(wq[dd & 3], rr * 4 + (dd >> 2)), z);
      const float ls = fminf(z, 0.f) - __logf(1.f + __expf(-fabsf(z)));
      bc[dd] = ls * (1.f / 16.f); }
#pragma unroll
    for (int off = 1; off < 64; off <<= 1) { float t[16];
      __builtin_amdgcn_sched_barrier(0);
#pragma unroll
      for (int dd = 0; dd < 16; ++dd) t[dd] = __shfl_up(bc[dd], off);
      __builtin_amdgcn_sched_barrier(0);
#pragma unroll
      for (int dd = 0; dd < 16; ++dd) bc[dd] += (lane >= off) ? t[dd] : 0.f; }
#pragma unroll
    for (int dd = 0; dd < 16; ++dd) bl[dd] = RLF(bc[dd], 63); }
#undef RLF
#pragma unroll
  for (int i2 = 0; i2 < 2; ++i2) { const int ch = 2 * cg + i2;
    bf16x8 q8 = q8s[i2]; const bf16x8 k8 = k8s[i2]; bf16x8 kb8;
#pragma unroll
    for (int e = 0; e < 8; ++e) { const int d = 8 * ch + e; const float bcv = bc[8 * i2 + e], blv = bl[8 * i2 + e]; const float kf = bf2f((bf16_t)k8[e]);
      q8[e] = (short)f2bf(bf2f((bf16_t)q8[e]) * 0.08838834764831845f * __expf(bcv)); kb8[e] = (short)f2bf(kf * __expf(-bcv)); KLT[d * P_T + srow] = f2bf(kf * __expf(blv - bcv));
      if (srow == 63) ((float*)(ws + WS_ADEC))[((size_t)bh * 64 + c) * 128 + d] = __expf(blv); }
    *(bf16x8*)(QB + srow * P_QK + 8 * ch) = q8; *(bf16x8*)(KB + srow * P_QK + 8 * ch) = kb8; *(bf16x8*)(GQK + tok * 1024 + h * 128 + 8 * ch) = q8; }
#pragma unroll
  for (int i4 = 0; i4 < 4; ++i4) { const int ch = 4 * cg + i4; const bf16x8 v8 = v8s[i4];
#pragma unroll
    for (int e = 0; e < 8; ++e) VT[(8 * ch + e) * P_T + srow] = (bf16_t)v8[e]; }
  __syncthreads();
  const int w = cg, i = lane & 15, gq = lane >> 4;
#pragma unroll
  for (int i2 = 0; i2 < 2; ++i2) { const int rt = w >> 1, ct = (w & 1) * 2 + i2; f32x4 acc = {0.f, 0.f, 0.f, 0.f};
#pragma unroll
    for (int ks = 0; ks < 4; ++ks) { const bf16x8 av = *(const bf16x8*)(QB + (16 * rt + i) * P_QK + 32 * ks + 8 * gq); const bf16x8 bv = *(const bf16x8*)(KB + (16 * ct + i) * P_QK + 32 * ks + 8 * gq);
      acc = __builtin_amdgcn_mfma_f32_16x16x32_bf16(av, bv, acc, 0, 0, 0); }
#pragma unroll
    for (int r = 0; r < 4; ++r) { const int t = 16 * rt + 4 * gq + r, s2 = 16 * ct + i; ATT[t * P_T + s2] = f2bf(s2 <= t ? acc[r] : 0.f); } }
  __syncthreads();
  { f32x4 acc[4][2];
#pragma unroll
    for (int rt = 0; rt < 4; ++rt) { acc[rt][0] = (f32x4){0.f, 0.f, 0.f, 0.f}; acc[rt][1] = (f32x4){0.f, 0.f, 0.f, 0.f}; }
#pragma unroll
    for (int ks = 0; ks < 2; ++ks) { bf16x8 bv[2];
#pragma unroll
      for (int ct = 0; ct < 2; ++ct) bv[ct] = *(const bf16x8*)(VT + (32 * w + 16 * ct + i) * P_T + 32 * ks + 8 * gq);
#pragma unroll
      for (int rt = 0; rt < 4; ++rt) { const bf16x8 av = *(const bf16x8*)(ATT + (16 * rt + i) * P_T + 32 * ks + 8 * gq);
        acc[rt][0] = __builtin_amdgcn_mfma_f32_16x16x32_bf16(av, bv[0], acc[rt][0], 0, 0, 0); acc[rt][1] = __builtin_amdgcn_mfma_f32_16x16x32_bf16(av, bv[1], acc[rt][1], 0, 0, 0); } }
    bf16_t* OT = (bf16_t*)(lds + L_QB); constexpr int PO = 264;
#pragma unroll
    for (int rt = 0; rt < 4; ++rt)
#pragma unroll
      for (int ct = 0; ct < 2; ++ct)
#pragma unroll
        for (int r = 0; r < 4; ++r) OT[(16 * rt + 4 * gq + r) * PO + 32 * w + 16 * ct + i] = f2bf(acc[rt][ct][r]); }
  __syncthreads();
  { const size_t tok0 = (size_t)b * SEQ + 64 * c; const bf16_t* OT = (const bf16_t*)(lds + L_QB); constexpr int PO = 264;
#pragma unroll
    for (int k = 0; k < 4; ++k) { const int id = tid + 512 * k, row = id >> 5, ch = id & 31; *(bf16x8*)(GV + (tok0 + row) * 1024 + h * 256 + 8 * ch) = *(const bf16x8*)(OT + row * PO + 8 * ch); } }
  { bf16_t* ST = (bf16_t*)(ws + WS_ST) + ((size_t)bh * 64 + c) * 256 * 128;
#pragma unroll
    for (int half = 0; half < 2; ++half) { f32x4 acc[4][2];
#pragma unroll
      for (int dt = 0; dt < 4; ++dt) { acc[dt][0] = (f32x4){0.f, 0.f, 0.f, 0.f}; acc[dt][1] = (f32x4){0.f, 0.f, 0.f, 0.f}; }
#pragma unroll
      for (int ks = 0; ks < 2; ++ks) { bf16x8 bv[2];
#pragma unroll
        for (int ct = 0; ct < 2; ++ct) bv[ct] = *(const bf16x8*)(VT + (32 * w + 16 * ct + i) * P_T + 32 * ks + 8 * gq);
#pragma unroll
        for (int dt = 0; dt < 4; ++dt) { const bf16x8 av = *(const bf16x8*)(KLT + (64 * half + 16 * dt + i) * P_T + 32 * ks + 8 * gq);
          acc[dt][0] = __builtin_amdgcn_mfma_f32_16x16x32_bf16(av, bv[0], acc[dt][0], 0, 0, 0); acc[dt][1] = __builtin_amdgcn_mfma_f32_16x16x32_bf16(av, bv[1], acc[dt][1], 0, 0, 0); } }
      bf16_t* MT = (bf16_t*)(lds + L_LA) + w * (32 * 72);
#pragma unroll
      for (int dt = 0; dt < 4; ++dt)
#pragma unroll
        for (int ct = 0; ct < 2; ++ct) { const int el = 16 * ct + i, d0 = 16 * dt + 4 * gq; const f32x4 v = acc[dt][ct];
          const unsigned lo = (unsigned)f2bf(v[0]) | ((unsigned)f2bf(v[1]) << 16), hi2 = (unsigned)f2bf(v[2]) | ((unsigned)f2bf(v[3]) << 16);
          *(unsigned long long*)(MT + el * 72 + d0) = (unsigned long long)lo | ((unsigned long long)hi2 << 32); }
      asm volatile("s_waitcnt lgkmcnt(0)" ::: "memory");
#pragma unroll
      for (int k = 0; k < 4; ++k) { const int id = lane + 64 * k, el = id >> 3, ch = id & 7;
        *(bf16x8*)(ST + (size_t)(32 * w + el) * 128 + 64 * half + 8 * ch) = *(const bf16x8*)(MT + el * 72 + 8 * ch); }
      asm volatile("s_waitcnt lgkmcnt(0)" ::: "memory"); } }
  __syncthreads();
}
__device__ __forceinline__ void scan(unsigned char* ws, const int bx, const int G) {
  typedef unsigned u32x2 __attribute__((ext_vector_type(2)));
  const int tid = threadIdx.x;
  for (int item = bx * 512 + tid; item < 16 * 256 * 32; item += G * 512) { const int bh = item >> 13, e = (item >> 5) & 255, dq = item & 31;
    float s0 = 0.f, s1 = 0.f, s2 = 0.f, s3 = 0.f;
    bf16_t* p = (bf16_t*)(ws + WS_ST) + ((size_t)bh * 64 * 256 + e) * 128 + 4 * dq; const float* ad = (const float*)(ws + WS_ADEC) + (size_t)bh * 64 * 128 + 4 * dq;
#pragma unroll 32
    for (int c = 0; c < 64; ++c) { const u32x2 m = *(const u32x2*)(p + (size_t)c * 256 * 128); const f32x4 a4 = *(const f32x4*)(ad + c * 128);
      u32x2 o; o.x = (unsigned)f2bf(s0) | ((unsigned)f2bf(s1) << 16); o.y = (unsigned)f2bf(s2) | ((unsigned)f2bf(s3) << 16); *(u32x2*)(p + (size_t)c * 256 * 128) = o;
      s0 = fmaf(a4[0], s0, __uint_as_float(m.x << 16)); s1 = fmaf(a4[1], s1, __uint_as_float(m.x & 0xffff0000u)); s2 = fmaf(a4[2], s2, __uint_as_float(m.y << 16)); s3 = fmaf(a4[3], s3, __uint_as_float(m.y & 0xffff0000u)); } }
}
__device__ __forceinline__ void passC(unsigned char* ws, unsigned char* Y8, char* lds, const float* __restrict__ gnorm, const int bh, const int c) {
  int tid_ = threadIdx.x; asm volatile("" : "+v"(tid_));
  const int tid = tid_, lane = tid & 63, i = lane & 15, gq = lane >> 4; const int w = __builtin_amdgcn_readfirstlane(tid >> 6);
  const int b = bh >> 2, h = bh & 3; const size_t tok0 = (size_t)b * SEQ + 64 * c;
  const bf16_t* GQK = (const bf16_t*)(ws + WS_GQK); bf16_t* GV = (bf16_t*)(ws + WS_GV); const bf16_t* GR = (const bf16_t*)(ws + WS_GR);
  const bf16_t* ST = (const bf16_t*)(ws + WS_ST) + ((size_t)bh * 64 + c) * 256 * 128;
  constexpr int PT = 264;
  bf16_t* OI = (bf16_t*)lds; bf16_t* GRT = (bf16_t*)(lds + 64 * PT * 2); float* red = (float*)(lds + 2 * 64 * PT * 2);
  bf16x8 oi[4], gr[4];
#pragma unroll
  for (int k = 0; k < 4; ++k) { const int id = tid + 512 * k, row = id >> 5, ch = id & 31; const size_t off = (tok0 + row) * 1024 + h * 256 + 8 * ch;
    oi[k] = *(const bf16x8*)(GV + off); gr[k] = *(const bf16x8*)(GR + off); }
  f32x4 acc[4][2];
#pragma unroll
  for (int rt = 0; rt < 4; ++rt) { acc[rt][0] = (f32x4){0.f, 0.f, 0.f, 0.f}; acc[rt][1] = (f32x4){0.f, 0.f, 0.f, 0.f}; }
#pragma unroll
  for (int ks = 0; ks < 4; ++ks) { bf16x8 bv[2];
#pragma unroll
    for (int ct = 0; ct < 2; ++ct) bv[ct] = *(const bf16x8*)(ST + (size_t)(32 * w + 16 * ct + i) * 128 + 32 * ks + 8 * gq);
#pragma unroll
    for (int rt = 0; rt < 4; ++rt) { const bf16x8 av = *(const bf16x8*)(GQK + (tok0 + 16 * rt + i) * 1024 + h * 128 + 32 * ks + 8 * gq);
      acc[rt][0] = __builtin_amdgcn_mfma_f32_16x16x32_bf16(av, bv[0], acc[rt][0], 0, 0, 0); acc[rt][1] = __builtin_amdgcn_mfma_f32_16x16x32_bf16(av, bv[1], acc[rt][1], 0, 0, 0); } }
#pragma unroll
  for (int k = 0; k < 4; ++k) { const int id = tid + 512 * k, row = id >> 5, ch = id & 31; *(bf16x8*)(OI + row * PT + 8 * ch) = oi[k]; *(bf16x8*)(GRT + row * PT + 8 * ch) = gr[k]; }
  __syncthreads();
  { float ssv[16];
#pragma unroll
    for (int rt = 0; rt < 4; ++rt)
#pragma unroll
      for (int r = 0; r < 4; ++r) { const int t = 16 * rt + 4 * gq + r; float ss = 0.f;
#pragma unroll
        for (int ct = 0; ct < 2; ++ct) { const float o = acc[rt][ct][r] + bf2f(OI[t * PT + 32 * w + 16 * ct + i]); acc[rt][ct][r] = o; ss += o * o; }
        ssv[4 * rt + r] = ss; }
#pragma unroll
    for (int off = 1; off < 16; off <<= 1) { float tt[16];
      __builtin_amdgcn_sched_barrier(0);
#pragma unroll
      for (int k = 0; k < 16; ++k) tt[k] = __shfl_xor(ssv[k], off);
      __builtin_amdgcn_sched_barrier(0);
#pragma unroll
      for (int k = 0; k < 16; ++k) ssv[k] += tt[k]; }
    if (i == 0) {
#pragma unroll
      for (int rt = 0; rt < 4; ++rt)
#pragma unroll
        for (int r = 0; r < 4; ++r) red[(16 * rt + 4 * gq + r) * 8 + w] = ssv[4 * rt + r]; } }
  __syncthreads();
#pragma unroll
  for (int rt = 0; rt < 4; ++rt)
#pragma unroll
    for (int r = 0; r < 4; ++r) { const int t = 16 * rt + 4 * gq + r; const f32x4 ra = *(const f32x4*)(red + t * 8), rb = *(const f32x4*)(red + t * 8 + 4);
      const float rs = rsqrtf(((ra[0] + ra[1]) + (ra[2] + ra[3]) + (rb[0] + rb[1]) + (rb[2] + rb[3])) * (1.f / 256.f) + EPS);
#pragma unroll
      for (int ct = 0; ct < 2; ++ct) { const int e = 32 * w + 16 * ct + i; const float rr = bf2f(GRT[t * PT + e]);
        OI[t * PT + e] = f2bf(acc[rt][ct][r] * rs * gnorm[e] * (rr * att::sigm(rr))); } }
  __syncthreads();
#pragma unroll
  for (int k = 0; k < 4; ++k) { const int id = tid + 512 * k, row = id >> 5, ch = id & 31; *(unsigned long long*)(Y8 + (tok0 + row) * 3072 + h * 256 + 8 * ch) = pg8::bf8_to_f8(*(const pg8::bf16x8*)(OI + row * PT + 8 * ch), 8.f); }
  __syncthreads();
}
}

namespace cg = cooperative_groups;
#define LAS __attribute__((address_space(3)))
typedef unsigned v4u __attribute__((ext_vector_type(4)));
typedef float f32x4 __attribute__((ext_vector_type(4)));
constexpr int NWAVES = 8, NTHREADS = 512, LDS_BYTES = 147456;
#define LDS_WAIT() asm volatile("s_waitcnt lgkmcnt(0)" ::: "memory")
__device__ __forceinline__ unsigned pk2(float lo, float hi) { return (unsigned)f2bf(lo) | ((unsigned)f2bf(hi) << 16); }


#define XB_TMO      128
#define XB_XCNT(j)  (256  + 64 * (j))
#define XB_XSUB(j)  (1280 + 64 * (j))
#define XB_XGEN(j)  (2304 + 64 * (j))
#define XB_TOP      3328
#define XB_TOPGEN   3392
#define XCD_BAR_WORDS 3456
#define XB_SPIN_CAP (1u << 18)

__device__ __forceinline__ unsigned xb_ld(unsigned* p)              { return __hip_atomic_load(p, __ATOMIC_RELAXED, __HIP_MEMORY_SCOPE_AGENT); }
__device__ __forceinline__ unsigned xb_add(unsigned* p, unsigned v) { return __hip_atomic_fetch_add(p, v, __ATOMIC_RELAXED, __HIP_MEMORY_SCOPE_AGENT); }
__device__ __forceinline__ unsigned xb_xcc_id() { return (unsigned)__builtin_amdgcn_s_getreg((3 << 11) | 20) & 0xFu; }
#define XB_SPIN(cond, bar) do { unsigned _sp = 0; while (cond) { __builtin_amdgcn_s_sleep(1); \
    if ((++_sp & 255u) == 0u) { if (xb_ld(&(bar)[XB_TMO])) break; if (_sp > XB_SPIN_CAP) { atomicAdd(&(bar)[XB_TMO], 1u); break; } } } } while (0)

struct XcdBarrier {
    unsigned* bar; unsigned x;
    volatile LAS unsigned* st;
};

__device__ __forceinline__ XcdBarrier xcd_barrier_post(unsigned* bar, volatile LAS unsigned* st) {
    XcdBarrier b; b.bar = bar; b.x = xb_xcc_id(); b.st = st;
    if (threadIdx.x == 0) (void)xb_add(&bar[XB_XCNT(b.x)], 1u);
    return b;
}
__device__ __forceinline__ void xcd_barrier_complete(unsigned* bar, unsigned x, unsigned& nloc, unsigned& nx) {
    const unsigned G = gridDim.x * gridDim.y * gridDim.z;
    unsigned sum, cnt, mine, sp = 0u;
    for (;;) {
        sum = 0u; cnt = 0u; mine = 0u;
#pragma unroll
        for (unsigned j = 0; j < 16; ++j) { const unsigned c = xb_ld(&bar[XB_XCNT(j)]); sum += c; cnt += (c > 0u) ? 1u : 0u; mine = (j == x) ? c : mine; }
        if (sum == G) break;
        __builtin_amdgcn_s_sleep(1);
        if ((++sp & 255u) == 0u) { if (xb_ld(&bar[XB_TMO])) break; if (sp > XB_SPIN_CAP) { atomicAdd(&bar[XB_TMO], 1u); break; } }
    }
    nloc = mine > 0u ? mine : 1u; nx = cnt > 0u ? cnt : 1u;
}

__device__ __forceinline__ void xcd_barrier(const XcdBarrier& b) {
    asm volatile("s_waitcnt vmcnt(0)" ::: "memory");
    __syncthreads();
    if (threadIdx.x == 0) {
        unsigned* bar = b.bar;
        __builtin_amdgcn_s_waitcnt(0);
        unsigned nloc = b.st[0], nx = b.st[1];
        if (nloc == 0u) { xcd_barrier_complete(bar, b.x, nloc, nx); b.st[0] = nloc; b.st[1] = nx; }
        const unsigned old = xb_add(&bar[XB_XSUB(b.x)], 1u);
        const unsigned gen = old / nloc;
        if (old + 1u == (gen + 1u) * nloc) {
            __builtin_amdgcn_fence(__ATOMIC_RELEASE, "agent");
            asm volatile("s_waitcnt vmcnt(0)" ::: "memory");
            const unsigned og = xb_add(&bar[XB_TOP], 1u);
            const unsigned tg = og / nx;
            if (og + 1u == (tg + 1u) * nx) xb_add(&bar[XB_TOPGEN], 1u);
            else XB_SPIN(xb_ld(&bar[XB_TOPGEN]) == tg, bar);
            __builtin_amdgcn_fence(__ATOMIC_ACQUIRE, "agent");
            xb_add(&bar[XB_XGEN(b.x)], 1u);
            asm volatile("s_waitcnt vmcnt(0)" ::: "memory");
        } else {
            XB_SPIN(xb_ld(&bar[XB_XGEN(b.x)]) == gen, bar);
            __builtin_amdgcn_fence(__ATOMIC_ACQUIRE, "agent");
            asm volatile("s_waitcnt vmcnt(0)" ::: "memory");
        }
    }
    __syncthreads();
}

struct Args { const float* in[23]; float* out; unsigned char* ws; int ph_lo, ph_hi, skip, pad; };

struct TrItem { const float* W; bf16_t* WT; const float* sc; int K, N, nblk, mode, item; unsigned char* W8; int lo8, ld8; };
__device__ __forceinline__ void tr_load(const TrItem& t, f32x4 (&v)[8], int lane) {
    const int kb = t.item / t.nblk, nb = t.item % t.nblk, k0 = 64 * kb, n0 = 32 * nb;
    const int np = n0 + 4 * (lane & 7); const int sn = t.mode ? src_col(np) : np; const bool ok = (sn >= 0) && (sn < t.N);
#pragma unroll
    for (int i = 0; i < 8; ++i) { const int kk = 8 * i + (lane >> 3); v[i] = ok ? __builtin_nontemporal_load((const f32x4*)(t.W + (size_t)(k0 + kk) * t.N + sn)) : (f32x4){0.f, 0.f, 0.f, 0.f}; }
}
__device__ __forceinline__ void tr_store(const TrItem& t, const f32x4 (&v)[8], LAS float* scr, int lane) {
    const int kb = t.item / t.nblk, nb = t.item % t.nblk, k0 = 64 * kb, n0 = 32 * nb;
#pragma unroll
    for (int i = 0; i < 8; ++i) { const int kk = 8 * i + (lane >> 3); const float sv = t.sc ? t.sc[k0 + kk] : 1.f; LAS float* d = scr + kk * 33 + 4 * (lane & 7);
        d[0] = v[i][0] * sv; d[1] = v[i][1] * sv; d[2] = v[i][2] * sv; d[3] = v[i][3] * sv; }
    LDS_WAIT(); asm volatile("" ::: "memory");
    const int c = lane & 7;
    if (t.W8 != nullptr && n0 >= t.lo8 && n0 < t.lo8 + 4096) {
#pragma unroll
      for (int j = 0; j < 4; ++j) { const int n = (lane >> 3) + 8 * j; const LAS float* s = scr + (8 * c) * 33 + n;
        int p0 = __builtin_amdgcn_cvt_pk_fp8_f32(s[0 * 33] * 64.f, s[1 * 33] * 64.f, 0, false); p0 = __builtin_amdgcn_cvt_pk_fp8_f32(s[2 * 33] * 64.f, s[3 * 33] * 64.f, p0, true);
        int p1 = __builtin_amdgcn_cvt_pk_fp8_f32(s[4 * 33] * 64.f, s[5 * 33] * 64.f, 0, false); p1 = __builtin_amdgcn_cvt_pk_fp8_f32(s[6 * 33] * 64.f, s[7 * 33] * 64.f, p1, true);
        *(unsigned long long*)(t.W8 + (size_t)(n0 + n - t.lo8) * t.ld8 + k0 + 8 * c) = (unsigned long long)(unsigned)p0 | ((unsigned long long)(unsigned)p1 << 32); }
    } else {
#pragma unroll
      for (int j = 0; j < 4; ++j) { const int n = (lane >> 3) + 8 * j; const LAS float* s = scr + (8 * c) * 33 + n;
        v4u o; o.x = pk2(s[0 * 33], s[1 * 33]); o.y = pk2(s[2 * 33], s[3 * 33]); o.z = pk2(s[4 * 33], s[5 * 33]); o.w = pk2(s[6 * 33], s[7 * 33]);
        *(v4u*)(t.WT + (size_t)(n0 + n) * t.K + k0 + 8 * c) = o; }
    }
    LDS_WAIT(); asm volatile("" ::: "memory");
}
__device__ __forceinline__ void rms_row_store(const f32x4 (&v)[8], const float* __restrict__ g, bf16_t* orow, unsigned char* orow8, int lane) {
    const f32x4* gr = (const f32x4*)g + lane; float s = 0.f;
#pragma unroll
    for (int j = 0; j < 8; ++j) s += (v[j].x * v[j].x + v[j].y * v[j].y) + (v[j].z * v[j].z + v[j].w * v[j].w);
    s = wave_sum(s); const float r = rsqrtf(s * (1.f / DM) + EPS);
    unsigned long long* o8 = (unsigned long long*)orow + lane;
#pragma unroll
    for (int j = 0; j < 8; ++j) { const f32x4 gg = gr[64 * j]; const float h0 = v[j].x * r * gg.x, h1 = v[j].y * r * gg.y, h2 = v[j].z * r * gg.z, h3 = v[j].w * r * gg.w;
        o8[64 * j] = (unsigned long long)pk2(h0, h1) | ((unsigned long long)pk2(h2, h3) << 32);
        int p8 = __builtin_amdgcn_cvt_pk_fp8_f32(h0, h1, 0, false); p8 = __builtin_amdgcn_cvt_pk_fp8_f32(h2, h3, p8, true); ((int*)orow8)[lane + 64 * j] = p8; }
}

__global__ void __launch_bounds__(NTHREADS, 2) mega(Args a) {
    extern __shared__ __attribute__((aligned(16))) unsigned char lds[];
    const int tid = threadIdx.x, lane = tid & 63, wave = __builtin_amdgcn_readfirstlane(tid >> 6);
    const int G = gridDim.x; const int bx = blockIdx.x;
    unsigned char* ws = a.ws;
    const int lo = a.ph_lo, hi = a.ph_hi; const int skip = a.skip;
#define SK(b) ((skip >> (b)) & 1)
    volatile LAS unsigned* bst = (volatile LAS unsigned*)((LAS unsigned char*)lds + (LDS_BYTES - 64));
    if (tid < 2) bst[tid] = 0u;
    __syncthreads();
    XcdBarrier xbar = xcd_barrier_post((unsigned*)(ws + WS_CTL) + 1024, bst);
#define GRID_BAR() xcd_barrier(xbar)
#define IN(k) (lo <= (k) && (k) < hi)
#define BOTH(k) (IN(k) && IN((k) + 1))
    if (IN(0)) {        LAS float* scr = (LAS float*)((LAS unsigned char*)lds + wave * 16384);
        const int gw = bx * NWAVES + wave, NGW = G * NWAVES;
        const float* x = a.in[0]; const int* pos = (const int*)a.in[1];
        constexpr int I_WIN = (DM / 64) * (NP / 32), I_W1 = (4096 / 64) * (128 / 32), I_W2 = (128 / 64) * (128 / 32);
        constexpr int NITEMS = I_WIN + 2 * I_W1 + 2 * I_W2;
        auto mk0 = [&](int it) __attribute__((always_inline)) { TrItem t; int r = it;
            if (r < I_WIN) { t = TrItem{a.in[3], (bf16_t*)(ws + WS_WINT), nullptr, DM, IN_COLS, NP / 32, 1, r, (unsigned char*)a.out + 32 * MiB, 8192, DM}; return t; } r -= I_WIN;
            if (r < I_W1) { t = TrItem{a.in[9], (bf16_t*)(ws + WS_W1T), nullptr, 4096, 128, 4, 0, r, nullptr, 0, 0}; return t; } r -= I_W1;
            if (r < I_W1) { t = TrItem{a.in[11], (bf16_t*)(ws + WS_W1T + MiB), nullptr, 4096, 128, 4, 0, r, nullptr, 0, 0}; return t; } r -= I_W1;
            if (r < I_W2) { t = TrItem{a.in[10], (bf16_t*)(ws + WS_SMALL + 64 * 1024), nullptr, 128, 128, 4, 0, r, nullptr, 0, 0}; return t; } r -= I_W2;
            t = TrItem{a.in[12], (bf16_t*)(ws + WS_SMALL + 128 * 1024), nullptr, 128, 128, 4, 0, r, nullptr, 0, 0}; return t; };
        { f32x4 vn[8]; TrItem tn{}; if (gw < NITEMS) { tn = mk0(gw); tr_load(tn, vn, lane); }
          for (int it = gw; it < NITEMS; it += NGW) { f32x4 vc[8]; const TrItem tc = tn;
#pragma unroll
            for (int i = 0; i < 8; ++i) vc[i] = vn[i];
            if (it + NGW < NITEMS) { tn = mk0(it + NGW); tr_load(tn, vn, lane); }
            tr_store(tc, vc, scr, lane); } }
        { f32x4 vn[8];
          if (gw < T) { const f32x4* xr = (const f32x4*)(x + (size_t)gw * DM) + lane;
#pragma unroll
            for (int j = 0; j < 8; ++j) vn[j] = __builtin_nontemporal_load(xr + 64 * j); }
          for (int m = gw; m < T; m += NGW) { f32x4 vc[8];
#pragma unroll
            for (int j = 0; j < 8; ++j) vc[j] = vn[j];
            if (m + NGW < T) { const f32x4* xr = (const f32x4*)(x + (size_t)(m + NGW) * DM) + lane;
#pragma unroll
              for (int j = 0; j < 8; ++j) vn[j] = __builtin_nontemporal_load(xr + 64 * j); }
            rms_row_store(vc, a.in[2], (bf16_t*)(ws + WS_HB) + (size_t)m * DM, (unsigned char*)a.out + (size_t)m * DM, lane); } }
        for (int idx = bx * NTHREADS + tid; idx < T * 16; idx += G * NTHREADS) { const int t = idx >> 4, i = idx & 15;
            const float inv = powf(500000.0f, -((float)(2 * i) / 32.0f)); const float ang = (float)pos[t] * inv;
            float* tab = (float*)(ws + WS_ROPE) + (size_t)idx * 2; tab[0] = cosf(ang); tab[1] = sinf(ang); }
        for (int it = gw; it < 256; it += NGW) { const int which = it >> 7, j = it & 127; const float* pp = a.in[which ? 8 : 7]; const float* w1 = a.in[which ? 11 : 9];
            float s = 0.f; for (int k = lane; k < 4096; k += 64) s += pp[k] * w1[(size_t)k * 128 + j]; s = wave_sum(s);
            if (lane == 0) ((float*)(ws + WS_SMALL))[which * 128 + j] = s; }
        if (BOTH(0)) GRID_BAR();
    }
    if (IN(1)) {
        pg8::Gemm g{(const bf16_t*)(ws + WS_HB), (const bf16_t*)(ws + WS_WINT), T, 8192, DM, DM}; pg8::StaticOrder S; S.init(T, 8192, G, bx);
        pg8::EpiRoute E{ws};
        pg8::gemm_phase<pg8::EpiRoute, pg8::StaticOrder, true, true>((PG8_LAS unsigned char*)lds, g, S, E);
        { pg8::Gemm g8{(const bf16_t*)a.out, (const bf16_t*)((const unsigned char*)a.out + 32 * MiB), T, 4096, 1024, 1024}; pg8::StaticOrder S8; S8.init(T, 4096, G, bx);
          pg8::EpiGateLogits E8{(bf16_t*)(ws + WS_GAB), (bf16_t*)(ws + WS_GAB + 64 * MiB)};
          pg8::gemm_phase<pg8::EpiGateLogits, pg8::StaticOrder, true, true, true>((PG8_LAS unsigned char*)lds, g8, S8, E8); }
        { pg8::Gemm g2{(const bf16_t*)(ws + WS_HB), (const bf16_t*)(ws + WS_WINT) + (size_t)12288 * DM, T, 256, 512, DM}; pg8::SplitKOrder S2{G, bx}; pg8::EpiSlab E2{(float*)(ws + WS_SMB)};
          pg8::gemm_phase<pg8::EpiSlab, pg8::SplitKOrder, true, true>((PG8_LAS unsigned char*)lds, g2, S2, E2); }
        if (BOTH(1)) GRID_BAR();
    }
    if (IN(2)) {        LAS float* scr = (LAS float*)((LAS unsigned char*)lds + wave * 16384);
        const int gw = bx * NWAVES + wave, NGW = G * NWAVES;
        constexpr int I_G = (1024 / 64) * (DM / 32), I_N = (DM / 64) * (DM / 32), I_Q = (DM / 64) * (1024 / 32);
        constexpr int NITEMS = I_G + 2 * I_N + I_Q;
        auto mk2 = [&](int it) __attribute__((always_inline)) { TrItem t; int r = it;
            if (r < I_G) { t = TrItem{a.in[13], (bf16_t*)(ws + WS_WGT), nullptr, 1024, DM, DM / 32, 0, r, (unsigned char*)a.out + 96 * MiB, 0, 3072}; return t; } r -= I_G;
            if (r < I_N) { t = TrItem{a.in[14], (bf16_t*)(ws + WS_WNT), nullptr, DM, DM, DM / 32, 0, r, (unsigned char*)a.out + 96 * MiB + 1024, 0, 3072}; return t; } r -= I_N;
            if (r < I_N) { t = TrItem{a.in[15], (bf16_t*)(ws + WS_WOT), nullptr, DM, DM, DM / 32, 0, r, nullptr, 0, 0}; return t; } r -= I_N;
            t = TrItem{a.in[17], (bf16_t*)(ws + WS_WQT), a.in[16], DM, 1024, 1024 / 32, 0, r, nullptr, 0, 0}; return t; };
        { f32x4 vn[8]; TrItem tn{}; if (gw < NITEMS) { tn = mk2(gw); tr_load(tn, vn, lane); }
          for (int it = gw; it < NITEMS; it += NGW) { f32x4 vc[8]; const TrItem tc = tn;
#pragma unroll
            for (int i = 0; i < 8; ++i) vc[i] = vn[i];
            if (it + NGW < NITEMS) { tn = mk2(it + NGW); tr_load(tn, vn, lane); }
            tr_store(tc, vc, scr, lane); } }
        __syncthreads();
        if (!SK(4)) for (int u = bx; u < 256; u += G) cmpu::cmp_unit(ws, (char*)lds, u >> 7, (u >> 3) & 15, u & 7);
        if (!SK(5)) for (int u = bx; u < 1024; u += G) gla::passA(ws, (char*)lds, a.in[4], a.in[5], u >> 6, u & 63);
        if (BOTH(2)) GRID_BAR();
    }
    if (IN(3)) {
        gla::scan(ws, bx, G);
        if (BOTH(3)) GRID_BAR();
    }
    if (IN(4)) {        const int vcu = (G % 8 == 0) ? (bx % 8) * (G / 8) + bx / 8 : bx;
        if (!SK(0)) for (int u = vcu; u < 256; u += G) { const int bg = u >> 4, s_ = u & 15;
#pragma unroll 1
            for (int k = 0; k < 4; ++k) { const int c = (k == 0) ? 63 - s_ : (k == 1) ? 32 + s_ : (k == 2) ? 31 - s_ : s_;
                att::nsa_unit(ws, (unsigned char*)a.out + 48 * MiB, (char*)lds, bg >> 2, bg & 3, c, skip); } }
        if (!SK(1)) for (int u = bx; u < 1024; u += G) gla::passC(ws, (unsigned char*)a.out + 48 * MiB, (char*)lds, a.in[6], u >> 6, u & 63);
        if (BOTH(4)) GRID_BAR();
    }
    if (IN(5)) {
        if (!SK(13)) { pg8::Gemm g{(const bf16_t*)((const unsigned char*)a.out + 48 * MiB), (const bf16_t*)((const unsigned char*)a.out + 96 * MiB), T, DM, 1536, 1536}; pg8::StaticOrder S; S.init(T, DM, G, bx); pg8::EpiGateFused E{ws, 1.f / 512.f};
          pg8::gemm_phase<pg8::EpiGateFused, pg8::StaticOrder, true, true, true>((PG8_LAS unsigned char*)lds, g, S, E); }
        if (BOTH(5)) GRID_BAR();
    }
    if (IN(6)) {
        pg8::Gemm g{(const bf16_t*)(ws + WS_MERGED), (const bf16_t*)(ws + WS_WOT), T, DM, DM, DM}; pg8::StaticOrder S; S.init(T, DM, G, bx); pg8::EpiOut E{ws, a.in[0], a.out};
        pg8::gemm_phase<pg8::EpiOut, pg8::StaticOrder, true, true>((PG8_LAS unsigned char*)lds, g, S, E);
        if (BOTH(6)) GRID_BAR();
    }
    if (IN(7)) {
        pg8::Gemm g{(const bf16_t*)(ws + WS_XB), (const bf16_t*)(ws + WS_WQT), T, 1024, DM, DM}; pg8::StaticOrder S; S.init(T, 1024, G, bx);
        float* rs_tab = (float*)(lds + 132096);
        { pg8::Unit u0; if (S.next(0, u0) && tid < 256) { const float* sp = (const float*)(ws + WS_W1T) + (size_t)(u0.pm * 256 + tid) * 32; float sq = 0.f;
#pragma unroll
            for (int k = 0; k < 8; ++k) { const f32x4 v = *(const f32x4*)(sp + 4 * k); sq += (v[0] + v[1]) + (v[2] + v[3]); }
            rs_tab[tid] = rsqrtf(sq * (1.f / 2048.f) + EPS); }
          __syncthreads(); }
        pg8::EpiQP E{ws, rs_tab};
        pg8::gemm_phase<pg8::EpiQP, pg8::StaticOrder, true, true>((PG8_LAS unsigned char*)lds, g, S, E);
        { const int gw = bx * NWAVES + wave, NGW = G * NWAVES; float* SC = (float*)(ws + WS_UB + 64 * MiB);
          f32x4 nv[8];
          if (!SK(8) && gw < 2 * 16384) { const float* src = a.in[20 + (gw >> 14)] + (size_t)(gw & 16383) * 2048 + 4 * lane;
#pragma unroll
            for (int q = 0; q < 8; ++q) nv[q] = __builtin_nontemporal_load((const f32x4*)(src + 256 * q)); }
          if (!SK(8)) for (int r = gw; r < 2 * 16384; r += NGW) { const int tab = r >> 14, e = r & 16383;
            f32x4 v[8]; float am = 0.f;
#pragma unroll
            for (int q = 0; q < 8; ++q) { v[q] = nv[q]; am = fmaxf(am, fmaxf(fmaxf(fabsf(v[q].x), fabsf(v[q].y)), fmaxf(fabsf(v[q].z), fabsf(v[q].w)))); }
            const int rn = r + NGW;
            if (rn < 2 * 16384) { const float* src = a.in[20 + (rn >> 14)] + (size_t)(rn & 16383) * 2048 + 4 * lane;
#pragma unroll
              for (int q = 0; q < 8; ++q) nv[q] = __builtin_nontemporal_load((const f32x4*)(src + 256 * q)); }
            am = wave_max(am); const float sc = am > 0.f ? am * (1.f / 384.f) : 1.f; const float inv = 1.f / sc;
            unsigned char* dstb = ws + WS_UB + (size_t)tab * 32 * MiB + (size_t)e * 128 + 4 * (lane & 31);
#pragma unroll
            for (int q = 0; q < 8; ++q) { int pk = __builtin_amdgcn_cvt_pk_fp8_f32(v[q].x * inv, v[q].y * inv, 0, false); pk = __builtin_amdgcn_cvt_pk_fp8_f32(v[q].z * inv, v[q].w * inv, pk, true);
              *(int*)(dstb + (size_t)(2 * q + (lane >> 5)) * 16384 * 128) = pk; }
            if (lane == 0) SC[r] = sc; } }
        if (BOTH(7)) GRID_BAR();
    }
    if (IN(8)) {
        for (int tile = bx; tile < T / 64; tile += G) {
            peer::route_tile(ws, (char*)lds, a.in[18], a.in[19], tile);
            __syncthreads();
            if (!SK(6)) peer::up_pass(ws, (char*)lds, a.in[16], tile);
            if (!SK(7)) peer::down_pass(ws, (char*)lds, a.out, a.in[22], tile);
            __syncthreads();
        }
    }
#undef IN
#undef BOTH
}

static int g_grid = 0;
static void launch_mega(Args& a, int lo, int hi, hipStream_t stream, int skip = 0) {
  a.ph_lo = lo; a.ph_hi = hi; a.skip = skip; a.pad = 0; void* args[] = {&a};
  (void)hipMemsetAsync(a.ws + WS_CTL, 0, 65536, stream);
  hipError_t e = hipLaunchCooperativeKernel((const void*)mega, dim3(g_grid), dim3(NTHREADS), args, LDS_BYTES, stream);
  if (e != hipSuccess) fprintf(stderr, "cooperative launch failed: %s (grid %d)\n", hipGetErrorString(e), g_grid);
}
extern "C" void kernel_launch(void* const* d_in, const int* in_sizes, int n_in, void* d_out, int out_size, void* d_ws, size_t ws_size, hipStream_t stream) {
  if (n_in != 23 || in_sizes[0] != T * DM || out_size != T * DM || ws_size < WS_END) { fprintf(stderr, "kernel_launch: bad shapes/ws: n_in %d ws %zu need %zu\n", n_in, ws_size, (size_t)WS_END); return; }
  if (g_grid == 0) {
    int dev = 0, cus = 0, per_cu = 0;
    (void)hipGetDevice(&dev); (void)hipDeviceGetAttribute(&cus, hipDeviceAttributeMultiprocessorCount, dev);
    if (hipFuncSetAttribute((const void*)mega, hipFuncAttributeMaxDynamicSharedMemorySize, LDS_BYTES) != hipSuccess) fprintf(stderr, "hipFuncSetAttribute(mega) failed\n");
    if (hipOccupancyMaxActiveBlocksPerMultiprocessor(&per_cu, (const void*)mega, NTHREADS, LDS_BYTES) != hipSuccess || per_cu < 1) { fprintf(stderr, "occupancy query failed (%d)\n", per_cu); per_cu = 1; }
    (void)hipGetLastError();
    g_grid = cus * (per_cu > 1 ? 1 : per_cu);
    fprintf(stderr, "mega: cus %d per_cu %d grid %d ws %zu MiB\n", cus, per_cu, g_grid, ws_size >> 20);
  }
  unsigned char* ws = (unsigned char*)d_ws; float* out = (float*)d_out;
  Args a{}; for (int i = 0; i < 23; ++i) a.in[i] = (const float*)d_in[i]; a.out = out; a.ws = ws;
#ifdef PROBE_K
#ifndef PROBE_SKIP
#define PROBE_SKIP 0
#endif
  launch_mega(a, 0, PROBE_K + 1, stream, 0);
  launch_mega(a, 0, PROBE_K + 1, stream, PROBE_SKIP);
#endif
  launch_mega(a, 0, 9, stream);
}
```

```cpp
#include <hip/hip_runtime.h>
#include <hip/hip_cooperative_groups.h>
#include <cstdio>
#include <cstdint>
#include <cmath>

typedef unsigned short bf16_t;
__host__ __device__ __forceinline__ float bf2f(bf16_t v) { union { unsigned u; float f; } c; c.u = (unsigned)v << 16; return c.f; }
__host__ __device__ __forceinline__ bf16_t f2bf(float f) {
#if defined(__HIP_DEVICE_COMPILE__)
  return __builtin_bit_cast(unsigned short, (__bf16)f);
#else
  union { unsigned u; float f; } c; c.f = f; unsigned u = c.u; return (bf16_t)((u + 0x7fffu + ((u >> 16) & 1u)) >> 16);
#endif
}

constexpr int BATCH = 4, SEQ = 4096, DM = 2048, T = BATCH * SEQ;
constexpr int NG = 4, HPG = 4, NH = 16, DH = 128;
constexpr int GH = 4, GDK = 128, GDV = 256;
constexpr int NCMP = 255, NSLC = 64;
constexpr int IN_COLS = 12352, NP = 12544;
constexpr float EPS = 1e-6f;
constexpr int PH = 8, PNK = 128, PTOPK = 16;
constexpr float ATT_SCALE = 0.08838834764831845f;

constexpr size_t MiB = 1u << 20;
constexpr size_t WS_CTL = 0;
constexpr size_t WS_ROPE = 1 * MiB;
constexpr size_t WS_SMALL = 3 * MiB;
constexpr size_t WS_W1T = 4 * MiB;
constexpr size_t WS_KC = 6 * MiB;
constexpr size_t WS_VC = 7 * MiB;
constexpr size_t WS_SMB = 513 * MiB;
constexpr size_t WS_WINT = 16 * MiB;
constexpr size_t WS_HB = 65 * MiB;
constexpr size_t WS_QY = 129 * MiB;
constexpr size_t WS_KV = 193 * MiB;
constexpr size_t WS_GQK = 289 * MiB;
constexpr size_t WS_GV = 321 * MiB;
constexpr size_t WS_GR = 353 * MiB;
constexpr size_t WS_GAB = 385 * MiB;
constexpr size_t WS_END = 529 * MiB;
constexpr size_t WS_ST = 16 * MiB;
constexpr size_t WS_WGT = 80 * MiB, WS_WNT = 84 * MiB, WS_WOT = 92 * MiB, WS_WQT = 100 * MiB;
constexpr size_t WS_TMP = 16 * MiB;
constexpr size_t WS_MERGED = 193 * MiB;
constexpr size_t WS_XB = 289 * MiB;
constexpr size_t WS_QP = 16 * MiB;
constexpr size_t WS_UB = 385 * MiB;

__host__ __device__ __forceinline__ int src_col(int np) {
  if (np < 5120) return np;
  if (np < 5632) return 5168 + (np - 5120);
  if (np < 6144) return 5680 + (np - 5632);
  if (np < 7168) return 6192 + (np - 6144);
  if (np < 8192) return 7232 + (np - 7168);
  if (np < 12288) { const int q = np - 8192; return 8256 + ((q >> 7) & 1) * 2048 + (q >> 8) * 128 + (q & 127); }
  if (np < 12336) return 5120 + (np - 12288);
  if (np < 12352) return 7216 + (np - 12336);
  return -1;
}
__device__ __forceinline__ float sigmoidf_(float x) { return 1.f / (1.f + __expf(-x)); }
__device__ __forceinline__ float gelu_tanh(float x) { return 0.5f * x * (1.f + tanhf(0.7978845608028654f * (x + 0.044715f * x * x * x))); }
__device__ __forceinline__ float wave_sum(float v) {
#pragma unroll
  for (int o = 32; o >= 1; o >>= 1) v += __shfl_xor(v, o);
  return v;
}
__device__ __forceinline__ float wave_max(float v) {
#pragma unroll
  for (int o = 32; o >= 1; o >>= 1) v = fmaxf(v, __shfl_xor(v, o));
  return v;
}

namespace pg8 {
#define PG8_LAS __attribute__((address_space(3)))
typedef short bf16x8 __attribute__((ext_vector_type(8)));
typedef float f32x4 __attribute__((ext_vector_type(4)));
typedef unsigned u32x4 __attribute__((ext_vector_type(4)));
typedef int v4i_t __attribute__((ext_vector_type(4)));
typedef int v8i_t __attribute__((ext_vector_type(8)));
constexpr int BM = 256, BK = 64, HALF = 128, HTB = HALF * BK * 2  , STAGE_BYTES = 8 * HTB, NXCD = 8, WGM = 4;

__host__ __device__ __forceinline__ int lds_byte(int r, int c) { const int st = (r >> 4) * 2 + (c >> 5), rr = r & 15, cc = c & 31, ob = rr * 64 + cc * 2; return st * 1024 + (ob ^ (((ob >> 9) & 1) << 5)); }
__host__ __device__ __forceinline__ void stage_rc(int b, int& R, int& C) { const int st = b / 1024, sb = b % 1024, swz = sb ^ (((sb >> 9) & 1) << 5); R = (st >> 1) * 16 + swz / 64; C = (st & 1) * 32 + (swz % 64) / 2; }
__host__ __device__ __forceinline__ int perm32(int rho) { const int n = rho >> 4, i = rho & 15; return 8 * (i >> 2) + 4 * n + (i & 3); }

struct Unit { int pm, pn, koff; };
struct Gemm { const bf16_t* A; const bf16_t* Bt; int M, N, K, ld; };

struct StaticOrder {
    int nM, nN, nwg, G, c;
    __host__ __device__ void init(int M, int N, int G_, int c_) { nM = M / BM; nN = N / BM; nwg = nM * nN; G = G_; c = c_; }
    __host__ __device__ __forceinline__ bool next(int i, Unit& u) const {
        const long L = (long)i * G + c; if (L >= nwg) return false;
        int wgid = (int)L; { const int q = nwg / NXCD, r = nwg % NXCD, xcd = wgid % NXCD, off = wgid / NXCD; wgid = (xcd < r ? xcd * (q + 1) : r * (q + 1) + (xcd - r) * q) + off; }
        const int nig = WGM * nN, gid = wgid / nig, fm = gid * WGM, gsz = (nM - fm) < WGM ? (nM - fm) : WGM;
        u.pm = fm + ((wgid % nig) % gsz); u.pn = (wgid % nig) / gsz; u.koff = 0; return true;
    }
    __device__ __forceinline__ void a_ready(const Unit&) const {}
    __device__ __forceinline__ void done(const Unit&) const {}
};


__device__ __forceinline__ unsigned cvt_pk_bf16(float lo, float hi) { unsigned r; asm volatile("v_cvt_pk_bf16_f32 %0, %1, %2" : "=v"(r) : "v"(lo), "v"(hi)); return r; }
__device__ __forceinline__ float bflo(unsigned w) { return __uint_as_float(w << 16); }
__device__ __forceinline__ float bfhi(unsigned w) { return __uint_as_float(w & 0xffff0000u); }
__device__ __forceinline__ unsigned long long bf8_to_f8(const bf16x8 v, const float sc) {
    typedef unsigned u4_t __attribute__((ext_vector_type(4))); const u4_t w = __builtin_bit_cast(u4_t, v);
#define F8C(x) __builtin_amdgcn_fmed3f((x) * sc, -448.f, 448.f)
    int p0 = __builtin_amdgcn_cvt_pk_fp8_f32(F8C(bflo(w.x)), F8C(bfhi(w.x)), 0, false); p0 = __builtin_amdgcn_cvt_pk_fp8_f32(F8C(bflo(w.y)), F8C(bfhi(w.y)), p0, true);
    int p1 = __builtin_amdgcn_cvt_pk_fp8_f32(F8C(bflo(w.z)), F8C(bfhi(w.z)), 0, false); p1 = __builtin_amdgcn_cvt_pk_fp8_f32(F8C(bflo(w.w)), F8C(bfhi(w.w)), p1, true);
#undef F8C
    return (unsigned long long)(unsigned)p0 | ((unsigned long long)(unsigned)p1 << 32);
}
__device__ __forceinline__ float sigm(float x) { return __builtin_amdgcn_rcpf(1.f + __builtin_amdgcn_exp2f(-1.4426950408889634f * x)); }
struct SplitKOrder { int G, c;
    __device__ __forceinline__ bool next(int i, Unit& u) const { const int L = i * G + c; if (L >= 256) return false; u.pm = L >> 2; u.pn = 0; u.koff = (L & 3) * 512; return true; }
    __device__ __forceinline__ void a_ready(const Unit&) const {}
    __device__ __forceinline__ void done(const Unit&) const {}
};
struct EpiSlab { static constexpr bool PERM = true, AFTER_DRAIN = false; float* smb4;
    __device__ __forceinline__ void operator()(const f32x4 (&acc)[2][2][4][2], const Unit& u, int wr, int wc, int fr, int fq) const {
        if (wc >= 2) return;
        float* base = smb4 + (size_t)(u.koff >> 9) * T * 64;
        const int row0 = u.pm * BM + wr * 64 + fr, col0 = wc * 32 + 8 * fq;
#pragma unroll
        for (int ai = 0; ai < 2; ++ai)
#pragma unroll
            for (int m = 0; m < 4; ++m) { float* rowp = base + (size_t)(row0 + ai * HALF + m * 16) * 64 + col0;
                *(f32x4*)rowp = acc[ai][0][m][0]; *(f32x4*)(rowp + 4) = acc[ai][0][m][1]; }
    }
};
struct EpiRoute { static constexpr bool PERM = true, AFTER_DRAIN = false; unsigned char* ws;
    __device__ __forceinline__ void operator()(const f32x4 (&acc)[2][2][4][2], const Unit& u, int wr, int wc, int fr, int fq) const {
        const int np0 = u.pn * BM; size_t boff; int ld, c0;
        if (np0 < 2048) { boff = WS_QY; ld = 2048; c0 = np0; } else if (np0 < 5120) { boff = WS_KV; ld = 3072; c0 = np0 - 2048; } else if (np0 < 6144) { boff = WS_GQK; ld = 1024; c0 = np0 - 5120; }
        else if (np0 < 7168) { boff = WS_GV; ld = 1024; c0 = np0 - 6144; } else if (np0 < 8192) { boff = WS_GR; ld = 1024; c0 = np0 - 7168; }
        else { boff = WS_GAB; ld = 4096; c0 = np0 - 8192; }
        bf16_t* base = (bf16_t*)(ws + boff);
        const int row0 = u.pm * BM + wr * 64 + fr, col0 = c0 + wc * 32 + 8 * fq;
        const bool rope = (wc == 0) && ((np0 < 2048) || (np0 >= 3072 && np0 < 3584) || (np0 >= 4096 && np0 < 4608));
        const float* tab = (const float*)(ws + WS_ROPE);
#pragma unroll
        for (int ai = 0; ai < 2; ++ai)
#pragma unroll
            for (int m = 0; m < 4; ++m) { const size_t row = (size_t)(row0 + ai * HALF + m * 16); bf16_t* rowp = base + row * ld + col0;
                f32x4 t0 = {1.f, 0.f, 1.f, 0.f}, t1 = t0, t2 = t0, t3 = t0;
                if (rope) { const f32x4* tb = (const f32x4*)(tab + (row * 16 + 8 * (fq & 1)) * 2); t0 = tb[0]; t1 = tb[1]; t2 = tb[2]; t3 = tb[3]; }
#pragma unroll
                for (int bj = 0; bj < 2; ++bj) { f32x4 v0 = acc[ai][bj][m][0], v1 = acc[ai][bj][m][1];
                    if (rope) { f32x4 p0, p1;
#pragma unroll
                        for (int e = 0; e < 4; ++e) { p0[e] = __shfl_xor(v0[e], 32); p1[e] = __shfl_xor(v1[e], 32); }
                        const float sg = (fq < 2) ? -1.f : 1.f;
                        v0[0] = v0[0] * t0[0] + sg * p0[0] * t0[1]; v0[1] = v0[1] * t0[2] + sg * p0[1] * t0[3]; v0[2] = v0[2] * t1[0] + sg * p0[2] * t1[1]; v0[3] = v0[3] * t1[2] + sg * p0[3] * t1[3];
                        v1[0] = v1[0] * t2[0] + sg * p1[0] * t2[1]; v1[1] = v1[1] * t2[2] + sg * p1[1] * t2[3]; v1[2] = v1[2] * t3[0] + sg * p1[2] * t3[1]; v1[3] = v1[3] * t3[2] + sg * p1[3] * t3[3]; }
                    u32x4 w; w.x = cvt_pk_bf16(v0[0], v0[1]); w.y = cvt_pk_bf16(v0[2], v0[3]); w.z = cvt_pk_bf16(v1[0], v1[1]); w.w = cvt_pk_bf16(v1[2], v1[3]);
                    *(u32x4*)(rowp + bj * HALF) = w; } }
    }
};
struct EpiGateLogits { static constexpr bool PERM = true, AFTER_DRAIN = false; bf16_t* rr; bf16_t* sb;
    __device__ __forceinline__ void operator()(const f32x4 (&acc)[2][2][4][2], const Unit& u, int wr, int wc, int fr, int fq) const {
        const int row0 = u.pm * BM + wr * 64 + fr, ch0 = u.pn * 128 + wc * 32 + 8 * fq; const float sc = -1.f / 64.f;
#pragma unroll
        for (int ai = 0; ai < 2; ++ai)
#pragma unroll
            for (int m = 0; m < 4; ++m) { const size_t off = (size_t)(row0 + ai * HALF + m * 16) * 2048 + ch0; float r[8], b[8];
#pragma unroll
                for (int n = 0; n < 2; ++n)
#pragma unroll
                    for (int j = 0; j < 4; ++j) { const float ea = __expf(acc[ai][0][m][n][j] * sc), eb = __expf(acc[ai][1][m][n][j] * sc); b[4 * n + j] = __builtin_amdgcn_rcpf(1.f + eb); r[4 * n + j] = (1.f + eb) * __builtin_amdgcn_rcpf(1.f + ea); }
                u32x4 w; w.x = cvt_pk_bf16(r[0], r[1]); w.y = cvt_pk_bf16(r[2], r[3]); w.z = cvt_pk_bf16(r[4], r[5]); w.w = cvt_pk_bf16(r[6], r[7]); *(u32x4*)(rr + off) = w;
                u32x4 x; x.x = cvt_pk_bf16(b[0], b[1]); x.y = cvt_pk_bf16(b[2], b[3]); x.z = cvt_pk_bf16(b[4], b[5]); x.w = cvt_pk_bf16(b[6], b[7]); *(u32x4*)(sb + off) = x; }
    }
};
struct EpiGateFused { static constexpr bool PERM = true, AFTER_DRAIN = false; static constexpr int MID_T = 8; unsigned char* ws; float sc;
    __device__ __forceinline__ void mid(f32x4 (&acc)[2][2][4][2], const Unit& u, int wr, int wc, int fr, int fq) const {
        const bf16_t* rr = (const bf16_t*)(ws + WS_GAB);
        int ln_ = threadIdx.x & 63; asm volatile("" : "+v"(ln_));
        const int row0 = u.pm * BM + wr * 64 + (ln_ & 15), col0 = u.pn * BM + wc * 32 + 8 * (ln_ >> 4);
#pragma unroll
        for (int ai = 0; ai < 2; ++ai) { u32x4 gq[4][2];
#pragma unroll
            for (int m = 0; m < 4; ++m)
#pragma unroll
                for (int bj = 0; bj < 2; ++bj) gq[m][bj] = *(const u32x4*)(rr + (size_t)(row0 + ai * HALF + m * 16) * 2048 + col0 + bj * HALF);
            __builtin_amdgcn_sched_barrier(0);
#pragma unroll
            for (int m = 0; m < 4; ++m)
#pragma unroll
                for (int bj = 0; bj < 2; ++bj) { const u32x4 g = gq[m][bj]; f32x4& v0 = acc[ai][bj][m][0]; f32x4& v1 = acc[ai][bj][m][1];
                    v0[0] *= bflo(g.x); v0[1] *= bfhi(g.x); v0[2] *= bflo(g.y); v0[3] *= bfhi(g.y); v1[0] *= bflo(g.z); v1[1] *= bfhi(g.z); v1[2] *= bflo(g.w); v1[3] *= bfhi(g.w); }
            __builtin_amdgcn_sched_barrier(0); }
    }
    __device__ __forceinline__ void operator()(const f32x4 (&acc)[2][2][4][2], const Unit& u, int wr, int wc, int fr, int fq) const {
        const bf16_t* sb = (const bf16_t*)(ws + WS_GAB + 64 * MiB); bf16_t* outp = (bf16_t*)(ws + WS_MERGED);
        const int row0 = u.pm * BM + wr * 64 + fr, col0 = u.pn * BM + wc * 32 + 8 * fq;
#pragma unroll
        for (int ai = 0; ai < 2; ++ai) { u32x4 gq[4][2];
#pragma unroll
            for (int m = 0; m < 4; ++m)
#pragma unroll
                for (int bj = 0; bj < 2; ++bj) gq[m][bj] = *(const u32x4*)(sb + (size_t)(row0 + ai * HALF + m * 16) * 2048 + col0 + bj * HALF);
            __builtin_amdgcn_sched_barrier(0);
#pragma unroll
            for (int m = 0; m < 4; ++m) { const size_t row = (size_t)(row0 + ai * HALF + m * 16);
#pragma unroll
                for (int bj = 0; bj < 2; ++bj) { const u32x4 g = gq[m][bj]; const f32x4 v0 = acc[ai][bj][m][0] * sc, v1 = acc[ai][bj][m][1] * sc;
                    u32x4 w; w.x = cvt_pk_bf16(v0[0] * bflo(g.x), v0[1] * bfhi(g.x)); w.y = cvt_pk_bf16(v0[2] * bflo(g.y), v0[3] * bfhi(g.y));
                    w.z = cvt_pk_bf16(v1[0] * bflo(g.z), v1[1] * bfhi(g.z)); w.w = cvt_pk_bf16(v1[2] * bflo(g.w), v1[3] * bfhi(g.w));
                    *(u32x4*)(outp + row * 2048 + col0 + bj * HALF) = w; } }
            __builtin_amdgcn_sched_barrier(0); }
    }
};
template <int STEP> struct EpiGate { static constexpr bool PERM = true, AFTER_DRAIN = false; unsigned char* ws; float sc;
    __device__ __forceinline__ void operator()(const f32x4 (&acc)[2][2][4][2], const Unit& u, int wr, int wc, int fr, int fq) const {
        const bf16_t* gab = (const bf16_t*)(ws + WS_GAB) + (STEP == 2 ? 2048 : 0); const bf16_t* tin = (const bf16_t*)(ws + WS_TMP); bf16_t* outp = (bf16_t*)(ws + (STEP == 2 ? WS_MERGED : WS_TMP));
        const int row0 = u.pm * BM + wr * 64 + fr, col0 = u.pn * BM + wc * 32 + 8 * fq;
#pragma unroll
        for (int ai = 0; ai < 2; ++ai) {
            u32x4 gq[4][2], tq[4][2];
#pragma unroll
            for (int m = 0; m < 4; ++m)
#pragma unroll
                for (int bj = 0; bj < 2; ++bj) { const size_t row = (size_t)(row0 + ai * HALF + m * 16); const int col = col0 + bj * HALF;
                    gq[m][bj] = *(const u32x4*)(gab + row * 4096 + col); if (STEP == 2) tq[m][bj] = *(const u32x4*)(tin + row * 2048 + col); }
            __builtin_amdgcn_sched_barrier(0);
#pragma unroll
            for (int m = 0; m < 4; ++m) { const size_t row = (size_t)(row0 + ai * HALF + m * 16);
#pragma unroll
                for (int bj = 0; bj < 2; ++bj) { const int col = col0 + bj * HALF; const f32x4 v0 = acc[ai][bj][m][0] * sc, v1 = acc[ai][bj][m][1] * sc; const u32x4 g = gq[m][bj];
                    float o0 = v0[0] * sigm(bflo(g.x)), o1 = v0[1] * sigm(bfhi(g.x)), o2 = v0[2] * sigm(bflo(g.y)), o3 = v0[3] * sigm(bfhi(g.y));
                    float o4 = v1[0] * sigm(bflo(g.z)), o5 = v1[1] * sigm(bfhi(g.z)), o6 = v1[2] * sigm(bflo(g.w)), o7 = v1[3] * sigm(bfhi(g.w));
                    if (STEP == 2) { const u32x4 t = tq[m][bj];
                        o0 += bflo(t.x); o1 += bfhi(t.x); o2 += bflo(t.y); o3 += bfhi(t.y); o4 += bflo(t.z); o5 += bfhi(t.z); o6 += bflo(t.w); o7 += bfhi(t.w); }
                    u32x4 w; w.x = cvt_pk_bf16(o0, o1); w.y = cvt_pk_bf16(o2, o3); w.z = cvt_pk_bf16(o4, o5); w.w = cvt_pk_bf16(o6, o7);
                    *(u32x4*)(outp + row * 2048 + col) = w; } }
            __builtin_amdgcn_sched_barrier(0); }
    }
};
struct EpiOut { static constexpr bool PERM = false, AFTER_DRAIN = false; unsigned char* ws; const float* x; float* out;
    __device__ __forceinline__ void operator()(const f32x4 (&acc)[2][2][4][2], const Unit& u, int wr, int wc, int fr, int fq) const {
        typedef unsigned u32x2v __attribute__((ext_vector_type(2)));
        bf16_t* xb = (bf16_t*)(ws + WS_XB); float* ssqp = (float*)(ws + WS_W1T);
        const int row0 = u.pm * BM + wr * 64 + fr, col0 = u.pn * BM + wc * 32 + 4 * fq;
#pragma unroll
        for (int ai = 0; ai < 2; ++ai) {
            f32x4 xv[4][2][2];
#pragma unroll
            for (int m = 0; m < 4; ++m)
#pragma unroll
                for (int bj = 0; bj < 2; ++bj)
#pragma unroll
                    for (int n = 0; n < 2; ++n) xv[m][bj][n] = *(const f32x4*)(x + (size_t)(row0 + ai * HALF + m * 16) * 2048 + col0 + bj * HALF + n * 16);
            __builtin_amdgcn_sched_barrier(0);
#pragma unroll
            for (int m = 0; m < 4; ++m) { const size_t row = (size_t)(row0 + ai * HALF + m * 16); float ss = 0.f;
#pragma unroll
                for (int bj = 0; bj < 2; ++bj)
#pragma unroll
                    for (int n = 0; n < 2; ++n) { const size_t off = row * 2048 + col0 + bj * HALF + n * 16; const f32x4 o = xv[m][bj][n] + acc[ai][bj][m][n];
                        u32x2v w; w.x = cvt_pk_bf16(o[0], o[1]); w.y = cvt_pk_bf16(o[2], o[3]); *(u32x2v*)(xb + off) = w;
                        ss += (o[0] * o[0] + o[1] * o[1]) + (o[2] * o[2] + o[3] * o[3]); }
                ss += __shfl_xor(ss, 16); ss += __shfl_xor(ss, 32);
                if (fq == 0) ssqp[row * 32 + u.pn * 4 + wc] = ss; }
            __builtin_amdgcn_sched_barrier(0); }
    }
};
struct EpiQP { static constexpr bool PERM = false, AFTER_DRAIN = false; unsigned char* ws; const float* rs_tab;
    __device__ __forceinline__ void operator()(const f32x4 (&acc)[2][2][4][2], const Unit& u, int wr, int wc, int fr, int fq) const {
        float* qp = (float*)(ws + WS_QP);
        const int rl0 = wr * 64 + fr, col0 = u.pn * BM + wc * 32 + 4 * fq;
#pragma unroll
        for (int ai = 0; ai < 2; ++ai)
#pragma unroll
            for (int m = 0; m < 4; ++m) { const int rl = rl0 + ai * HALF + m * 16; const size_t row = (size_t)(u.pm * BM + rl); const float rs = rs_tab[rl];
#pragma unroll
                for (int bj = 0; bj < 2; ++bj)
#pragma unroll
                    for (int n = 0; n < 2; ++n) *(f32x4*)(qp + row * 1024 + col0 + bj * HALF + n * 16) = acc[ai][bj][m][n] * rs; }
    }
};

template <class...> struct void_tt { typedef void type; };
template <class E, class = void> struct mid_t { static constexpr int v = 0; };
template <class E> struct mid_t<E, typename void_tt<decltype(E::MID_T)>::type> { static constexpr int v = E::MID_T; };
template <class Epi, class Sched, bool ALIGN_EPI = false, bool SP2 = false, bool F8 = false>
__device__ __forceinline__ void gemm_phase(PG8_LAS unsigned char* lds, const Gemm g, const Sched& S, const Epi& E) {
    const int tid = threadIdx.x, wid = __builtin_amdgcn_readfirstlane(tid >> 6), lane = tid & 63, wr = wid >> 2, wc = wid & 3, fr = lane & 15, fq = lane >> 4;
    const int K = g.K, nt = K / BK;
    unsigned voffA[2], voffB[2];
#pragma unroll
    for (int i = 0; i < 2; ++i) { int R, C; stage_rc(tid * 16 + i * 8192, R, C); const int Rb = Epi::PERM ? ((R & ~31) + perm32(R & 31)) : R;
        voffA[i] = (unsigned)(R * g.ld + C) * 2u; voffB[i] = (unsigned)(Rb * g.ld + C) * 2u; }
    const size_t kstep = (size_t)(BK * 2);
    const size_t hstep = (size_t)HALF * g.ld * 2;
    const size_t tstep = 2 * hstep;
    const unsigned ldsw = (unsigned)wid * 1024u;
    const int aoff = lds_byte(wr * 64 + fr, F8 ? fq * 16 : fq * 8), boff = lds_byte(wc * 32 + fr, F8 ? fq * 16 : fq * 8);
#define PG8_SA(b, h) (((b) * 2 + (h)) * HTB)
#define PG8_SB(b, h) ((4 + (b) * 2 + (h)) * HTB)
#define PG8_STAGE(bufoff, gbase, voff) do { _Pragma("unroll") for (int _i = 0; _i < 2; ++_i) \
        __builtin_amdgcn_global_load_lds((const unsigned*)((const char*)(gbase) + (voff)[_i]), (PG8_LAS unsigned*)(lds + (bufoff) + ldsw + _i * 8192), 16, 0, 0); } while (0)
#define PG8_LDA(dst, b, h) do { if constexpr (F8) { _Pragma("unroll") for (int m = 0; m < 4; ++m) dst##8[m] = *(const PG8_LAS v8i_t*)(lds + PG8_SA(b, h) + aoff + m * 2048); } \
        else { _Pragma("unroll") for (int m = 0; m < 4; ++m) _Pragma("unroll") for (int k = 0; k < 2; ++k) dst[m][k] = *(const PG8_LAS bf16x8*)(lds + PG8_SA(b, h) + aoff + m * 2048 + k * 1024); } } while (0)
#define PG8_LDB(dst, b, h) do { if constexpr (F8) { _Pragma("unroll") for (int n = 0; n < 2; ++n) dst##8[n] = *(const PG8_LAS v8i_t*)(lds + PG8_SB(b, h) + boff + n * 2048); } \
        else { _Pragma("unroll") for (int n = 0; n < 2; ++n) _Pragma("unroll") for (int k = 0; k < 2; ++k) dst[n][k] = *(const PG8_LAS bf16x8*)(lds + PG8_SB(b, h) + boff + n * 2048 + k * 1024); } } while (0)
#define PG8_MMA(ai, bj, At, Bt) do { __builtin_amdgcn_s_setprio(1); if constexpr (F8) { _Pragma("unroll") for (int m = 0; m < 4; ++m) _Pragma("unroll") for (int n = 0; n < 2; ++n) \
          asm volatile("v_mfma_scale_f32_16x16x128_f8f6f4 %0, %1, %2, %0, %3, %3 op_sel_hi:[0,0,0]" : "+v"(acc[ai][bj][m][n]) : "v"(Bt##8[n]), "v"(At##8[m]), "v"(scale1)); } \
        else { _Pragma("unroll") for (int m = 0; m < 4; ++m) _Pragma("unroll") for (int n = 0; n < 2; ++n) _Pragma("unroll") for (int k = 0; k < 2; ++k) \
        acc[ai][bj][m][n] = __builtin_amdgcn_mfma_f32_16x16x32_bf16(Bt[n][k], At[m][k], acc[ai][bj][m][n], 0, 0, 0); } __builtin_amdgcn_s_setprio(0); } while (0)
#define PG8_WAIT_V(n) asm volatile("s_waitcnt vmcnt(" #n ")" ::: "memory")
#define PG8_WAIT_L(n) asm volatile("s_waitcnt lgkmcnt(" #n ")" ::: "memory")
#define PG8_BAR __builtin_amdgcn_s_barrier()
#define PG8_SCHED __builtin_amdgcn_sched_barrier(0)
    Unit cur, nxt; int ui = 0;
    if (!S.next(0, cur)) return;
    f32x4 acc[2][2][4][2];
#pragma unroll
    for (int a = 0; a < 2; ++a)
#pragma unroll
        for (int b = 0; b < 2; ++b)
#pragma unroll
            for (int m = 0; m < 4; ++m)
#pragma unroll
                for (int n = 0; n < 2; ++n) acc[a][b][m][n] = (f32x4){0.f, 0.f, 0.f, 0.f};
    bf16x8 At[4][2], B0[2][2], B1[2][2]; v8i_t At8[4], B08[2], B18[2]; int scale1 = 0x7F7F7F7F; asm volatile("" : "+v"(scale1));
    (void)At8; (void)B08; (void)B18;
    const char* cA = (const char*)g.A + (size_t)cur.pm * tstep + (size_t)cur.koff * 2; const char* cB = (const char*)g.Bt + (size_t)cur.pn * tstep + (size_t)cur.koff * 2;
    S.a_ready(cur);
    if constexpr (SP2) {
        PG8_STAGE(PG8_SB(0, 0), cB, voffB); PG8_STAGE(PG8_SB(0, 1), cB + hstep, voffB); PG8_STAGE(PG8_SA(0, 0), cA, voffA); PG8_STAGE(PG8_SA(0, 1), cA + hstep, voffA);
        if (wr == 1) PG8_BAR;
        PG8_WAIT_V(2); PG8_BAR;
        PG8_STAGE(PG8_SB(1, 0), cB + kstep, voffB); PG8_STAGE(PG8_SA(1, 0), cA + kstep, voffA); PG8_STAGE(PG8_SB(1, 1), cB + hstep + kstep, voffB);
        PG8_WAIT_V(6); PG8_BAR;
    } else {
        PG8_STAGE(PG8_SB(0, 0), cB, voffB); PG8_STAGE(PG8_SA(0, 0), cA, voffA); PG8_STAGE(PG8_SB(0, 1), cB + hstep, voffB); PG8_STAGE(PG8_SA(0, 1), cA + hstep, voffA);
        if (wr == 1) PG8_BAR;
        PG8_WAIT_V(4); PG8_BAR;
        PG8_STAGE(PG8_SB(1, 0), cB + kstep, voffB); PG8_STAGE(PG8_SA(1, 0), cA + kstep, voffA); PG8_STAGE(PG8_SB(1, 1), cB + hstep + kstep, voffB);
        PG8_WAIT_V(6); PG8_BAR;
    }
    for (;;) {
        const bool has_next = S.next(ui + 1, nxt);
        const char* nA = has_next ? (const char*)g.A + (size_t)nxt.pm * tstep + (size_t)nxt.koff * 2 : cA; const char* nB = has_next ? (const char*)g.Bt + (size_t)nxt.pn * tstep + (size_t)nxt.koff * 2 : cB;
        for (int t = 0; t < nt; t += 2) {
            if constexpr (mid_t<Epi>::v > 0) { if (t == mid_t<Epi>::v) {
                if constexpr (ALIGN_EPI) { if (wr == 0) PG8_BAR; }
                if constexpr (F8) asm volatile("s_nop 15\n\ts_nop 15" ::: "memory");
                E.mid(acc, cur, wr, wc, fr, fq);
                if constexpr (F8) asm volatile("s_nop 7" ::: "memory");
                if constexpr (ALIGN_EPI) { if (wr == 1) PG8_BAR; } } }
            const bool last = (t == nt - 2);
            const char* a1 = cA + (size_t)(t + 1) * kstep;
            const char* a2 = last ? nA : cA + (size_t)(t + 2) * kstep; const char* b2 = last ? nB : cB + (size_t)(t + 2) * kstep;
            const char* a3 = a2 + kstep; const char* b3 = b2 + kstep;
            if (last && has_next) S.a_ready(nxt);
            if constexpr (SP2) {
            PG8_LDB(B0, 0, 0); PG8_LDB(B1, 0, 1); PG8_SCHED; PG8_LDA(At, 0, 0); PG8_STAGE(PG8_SA(1, 1), a1 + hstep, voffA);
            PG8_WAIT_V(8); PG8_WAIT_L(0); PG8_BAR; PG8_MMA(0, 0, At, B0); PG8_MMA(0, 1, At, B1); PG8_BAR; PG8_SCHED;
            PG8_LDA(At, 0, 1); PG8_STAGE(PG8_SB(0, 0), b2, voffB); PG8_STAGE(PG8_SB(0, 1), b2 + hstep, voffB); PG8_STAGE(PG8_SA(0, 0), a2, voffA);
            PG8_WAIT_V(8); PG8_WAIT_L(0); PG8_BAR; PG8_MMA(1, 0, At, B0); PG8_MMA(1, 1, At, B1); PG8_BAR; PG8_SCHED;
            PG8_LDB(B0, 1, 0); PG8_LDB(B1, 1, 1); PG8_SCHED; PG8_LDA(At, 1, 0); PG8_STAGE(PG8_SA(0, 1), a2 + hstep, voffA);
            PG8_WAIT_V(8); PG8_WAIT_L(0); PG8_BAR; PG8_MMA(0, 0, At, B0); PG8_MMA(0, 1, At, B1); PG8_BAR; PG8_SCHED;
            PG8_LDA(At, 1, 1); PG8_STAGE(PG8_SB(1, 0), b3, voffB); PG8_STAGE(PG8_SB(1, 1), b3 + hstep, voffB); PG8_STAGE(PG8_SA(1, 0), a3, voffA);
            PG8_WAIT_V(8); PG8_WAIT_L(0); PG8_BAR; PG8_MMA(1, 0, At, B0); PG8_MMA(1, 1, At, B1); PG8_BAR; PG8_SCHED;
            } else {
            PG8_LDB(B0, 0, 0); PG8_SCHED; PG8_LDA(At, 0, 0); PG8_STAGE(PG8_SA(1, 1), a1 + hstep, voffA);
            PG8_WAIT_L(8); PG8_BAR; PG8_WAIT_L(0); PG8_MMA(0, 0, At, B0); PG8_BAR; PG8_SCHED;
            PG8_LDB(B1, 0, 1); PG8_STAGE(PG8_SB(0, 0), b2, voffB);
            PG8_BAR; PG8_WAIT_L(0); PG8_MMA(0, 1, At, B1); PG8_BAR;
            PG8_LDA(At, 0, 1); PG8_STAGE(PG8_SA(0, 0), a2, voffA);
            PG8_BAR; PG8_WAIT_L(0); PG8_MMA(1, 0, At, B0); PG8_BAR; PG8_SCHED;
            PG8_STAGE(PG8_SB(0, 1), b2 + hstep, voffB);
            PG8_WAIT_V(6); PG8_BAR; PG8_MMA(1, 1, At, B1); PG8_BAR;
            PG8_LDB(B0, 1, 0); PG8_SCHED; PG8_LDA(At, 1, 0); PG8_STAGE(PG8_SA(0, 1), a2 + hstep, voffA);
            PG8_WAIT_L(8); PG8_BAR; PG8_WAIT_L(0); PG8_MMA(0, 0, At, B0); PG8_BAR; PG8_SCHED;
            PG8_LDB(B1, 1, 1); PG8_STAGE(PG8_SB(1, 0), b3, voffB);
            PG8_BAR; PG8_WAIT_L(0); PG8_MMA(0, 1, At, B1); PG8_BAR;
            PG8_LDA(At, 1, 1); PG8_STAGE(PG8_SA(1, 0), a3, voffA);
            PG8_BAR; PG8_WAIT_L(0); PG8_MMA(1, 0, At, B0); PG8_BAR; PG8_SCHED;
            PG8_STAGE(PG8_SB(1, 1), b3 + hstep, voffB);
            PG8_WAIT_V(6); PG8_BAR; PG8_MMA(1, 1, At, B1); PG8_BAR;
            }
        }
        if constexpr (ALIGN_EPI) { if (wr == 0) PG8_BAR; }
        if constexpr (F8) asm volatile("s_nop 15\n\ts_nop 15" ::: "memory");
        if constexpr (!Epi::AFTER_DRAIN) { E(acc, cur, wr, wc, fr, fq); S.done(cur); }
        if (!has_next) break;
#pragma unroll
        for (int a = 0; a < 2; ++a)
#pragma unroll
            for (int b = 0; b < 2; ++b)
#pragma unroll
                for (int m = 0; m < 4; ++m)
#pragma unroll
                    for (int n = 0; n < 2; ++n) acc[a][b][m][n] = (f32x4){0.f, 0.f, 0.f, 0.f};
        cur = nxt; cA = nA; cB = nB; ++ui;
        if constexpr (ALIGN_EPI) { if (wr == 1) PG8_BAR; }
    }
    PG8_WAIT_V(0);
    if constexpr (!ALIGN_EPI) { if (wr == 0) PG8_BAR; }
    PG8_BAR;
    if constexpr (Epi::AFTER_DRAIN) { E.fused(acc, cur, wr, wc, fr, fq, lds, wid, lane); S.done(cur); }
#undef PG8_SA
#undef PG8_SB
#undef PG8_STAGE
#undef PG8_LDA
#undef PG8_LDB
#undef PG8_MMA
#undef PG8_WAIT_V
#undef PG8_WAIT_L
#undef PG8_BAR
#undef PG8_SCHED
}
}


namespace att {
using bf16x8 = __attribute__((ext_vector_type(8))) short;
using s16x4  = __attribute__((ext_vector_type(4))) short;
using f32x16 = __attribute__((ext_vector_type(16))) float;
using f32x4  = __attribute__((ext_vector_type(4))) float;
using u32x4  = __attribute__((ext_vector_type(4))) unsigned;
constexpr int SHM_V = 16384, SHM_K = 16384;
constexpr int L_V = 0, L_K = 32768, L_WSF = 65536, L_IMPG = 67584, L_IMPE = L_IMPG + 16384, L_IMPF = L_IMPE + 16384, L_OACC = L_IMPG, L_SEL = L_OACC + 65536, L_LIST = L_SEL + 512, L_GATE = 140288  , L_END = L_GATE + 8 * 96 * 4;
static_assert(L_END <= 147456 - 1024, "attention LDS map");
constexpr float C2 = 0.08838834764831845f * 1.4426950408889634f;
#define KSWZ(row, colB) ((row) * 256 + ((colB) ^ (((row) & 7) << 4)))
#define SBAR() __builtin_amdgcn_sched_barrier(0)
__device__ __forceinline__ int crow(int r, int hi) { return (r & 3) + 8 * (r >> 2) + 4 * hi; }
__device__ __forceinline__ unsigned cvtpk(float lo, float hi) { unsigned r; asm volatile("v_cvt_pk_bf16_f32 %0, %1, %2" : "=v"(r) : "v"(lo), "v"(hi)); return r; }
__device__ __forceinline__ float sigm(float x) { return __builtin_amdgcn_rcpf(1.f + __builtin_amdgcn_exp2f(-1.4426950408889634f * x)); }
__device__ __forceinline__ void qkt(f32x16& p0, f32x16& p1, const char* Ks, const bf16x8* qr, int r32, int hi) {
  p0 = f32x16{}; p1 = f32x16{};
#pragma unroll
  for (int d0 = 0; d0 < 8; ++d0) { int cb = (d0 * 16 + hi * 8) * 2;
    bf16x8 b0 = *reinterpret_cast<const bf16x8*>(Ks + KSWZ(r32, cb));
    bf16x8 b1 = *reinterpret_cast<const bf16x8*>(Ks + KSWZ(32 + r32, cb));
    p0 = __builtin_amdgcn_mfma_f32_32x32x16_bf16(b0, qr[d0], p0, 0, 0, 0);
    p1 = __builtin_amdgcn_mfma_f32_32x32x16_bf16(b1, qr[d0], p1, 0, 0, 0); }
}
__device__ __forceinline__ int v_st(int k, int c) { const int kk = (k & ~0xC) | ((k & 4) << 1) | ((k & 8) >> 1); return ((kk >> 3) * 4 + (c >> 5)) * 512 + ((kk & 7) * 32 + (c & 31)) * 2; }
__device__ __forceinline__ int v_rd_base(int lane) { return ((lane & 3) << 3) | (((lane >> 2) & 3) << 6) | (((lane >> 4) & 1) << 5) | (((lane >> 5) & 1) << 8); }
constexpr int v_rd_off(int d0, int ks, int half) { return d0 * 512 + ks * 4096 + half * 2048; }
template <int OFF> __device__ __forceinline__ s16x4 tr_read(int vb) {
  s16x4 r; asm volatile("ds_read_b64_tr_b16 %0, %1 offset:%2" : "=&v"(r) : "v"(vb), "i"(OFF) : "memory"); return r;
}
template <int D0> __device__ __forceinline__ void pv_one(f32x16& od, int vb, bf16x8 pa0, bf16x8 pa1, bf16x8 pa2, bf16x8 pa3) {
  const s16x4 l0 = tr_read<v_rd_off(D0, 0, 0)>(vb), h0 = tr_read<v_rd_off(D0, 0, 1)>(vb), l1 = tr_read<v_rd_off(D0, 1, 0)>(vb), h1 = tr_read<v_rd_off(D0, 1, 1)>(vb);
  const s16x4 l2 = tr_read<v_rd_off(D0, 2, 0)>(vb), h2 = tr_read<v_rd_off(D0, 2, 1)>(vb), l3 = tr_read<v_rd_off(D0, 3, 0)>(vb), h3 = tr_read<v_rd_off(D0, 3, 1)>(vb);
  asm volatile("s_waitcnt lgkmcnt(0)" ::: "memory"); SBAR();
#define PK(L, H) (bf16x8){L[0], L[1], L[2], L[3], H[0], H[1], H[2], H[3]}
  od = __builtin_amdgcn_mfma_f32_32x32x16_bf16(pa0, PK(l0, h0), od, 0, 0, 0);
  od = __builtin_amdgcn_mfma_f32_32x32x16_bf16(pa1, PK(l1, h1), od, 0, 0, 0);
  od = __builtin_amdgcn_mfma_f32_32x32x16_bf16(pa2, PK(l2, h2), od, 0, 0, 0);
  od = __builtin_amdgcn_mfma_f32_32x32x16_bf16(pa3, PK(l3, h3), od, 0, 0, 0);
#undef PK
}
__device__ __forceinline__ void pv_d0(f32x16* o, int vb, bf16x8 pa0, bf16x8 pa1, bf16x8 pa2, bf16x8 pa3) {
  pv_one<0>(o[0], vb, pa0, pa1, pa2, pa3); pv_one<1>(o[1], vb, pa0, pa1, pa2, pa3); pv_one<2>(o[2], vb, pa0, pa1, pa2, pa3); pv_one<3>(o[3], vb, pa0, pa1, pa2, pa3);
}
__device__ __forceinline__ float qx1(float v) { return __int_as_float(__builtin_amdgcn_update_dpp(0, __float_as_int(v), 0xB1, 0xF, 0xF, true)); }
__device__ __forceinline__ float qx2(float v) { return __int_as_float(__builtin_amdgcn_update_dpp(0, __float_as_int(v), 0x4E, 0xF, 0xF, true)); }
__device__ __forceinline__ float qm8(float v) { return __int_as_float(__builtin_amdgcn_update_dpp(0, __float_as_int(v), 0x141, 0xF, 0xF, true)); }
__device__ __forceinline__ float qm16(float v) { return __int_as_float(__builtin_amdgcn_update_dpp(0, __float_as_int(v), 0x140, 0xF, 0xF, true)); }
__device__ __forceinline__ float half_max(float v) { auto rr = __builtin_amdgcn_permlane32_swap(__float_as_uint(v), __float_as_uint(v), false, false); return fmaxf(__uint_as_float(rr[0]), __uint_as_float(rr[1])); }
__device__ __forceinline__ float half_sum(float v) { auto rr = __builtin_amdgcn_permlane32_swap(__float_as_uint(v), __float_as_uint(v), false, false); return __uint_as_float(rr[0]) + __uint_as_float(rr[1]); }
#define PK4(P, BASE, OUT) do { unsigned a0_ = cvtpk(P[BASE + 0], P[BASE + 1]), a1_ = cvtpk(P[BASE + 2], P[BASE + 3]);   \
    unsigned b0_ = cvtpk(P[BASE + 4], P[BASE + 5]), b1_ = cvtpk(P[BASE + 6], P[BASE + 7]);                              \
    auto r0_ = __builtin_amdgcn_permlane32_swap(a0_, b0_, false, false); auto r1_ = __builtin_amdgcn_permlane32_swap(a1_, b1_, false, false); \
    u32x4 w_ = {r0_[0], r1_[0], r0_[1], r1_[1]}; OUT = *reinterpret_cast<bf16x8*>(&w_); } while (0)

struct Stg { bf16x8 vs0, vs1, ks0, ks1; };
template <int MODE>
__device__ __forceinline__ void run_branch(char* lds, const bf16_t* __restrict__ Kp, const bf16_t* __restrict__ Vp, const int pitch, const int* list, const int nt,
                                           const bf16x8 (&qr)[8], f32x16 (&o)[4], float& m_reg, float& l_reg, const int c, const int tk, const int t0,
                                           const unsigned sel_lo, const unsigned sel_hi, const float inv_l, const float gate0) {
  int tid_ = threadIdx.x; asm volatile("" : "+v"(tid_));
  const int tid = tid_, wid = tid >> 6, lane = tid & 63, r32 = lane & 31, hi = lane >> 5;
  char* V_lds = lds + L_V; char* K_lds = lds + L_K;
  float* al_l = (float*)(lds + L_WSF) + wid * 64 + 32;
  float* impG = (float*)(lds + L_IMPG); float* impE = (float*)(lds + L_IMPE);
  const int sr = tid >> 4, sc = (tid & 15) * 8, vst0 = v_st(sr, sc), vst1 = v_st(32 + sr, sc);
  const int vb0 = (int)(uintptr_t)V_lds + v_rd_base(lane);
  Stg sA, sB;
#define SLOAD(st, jj) do { const size_t r0_ = (size_t)(jj) * 64; st.vs0 = *(const bf16x8*)(Vp + (r0_ + sr) * pitch + sc); st.vs1 = *(const bf16x8*)(Vp + (r0_ + 32 + sr) * pitch + sc); \
    st.ks0 = *(const bf16x8*)(Kp + (r0_ + sr) * pitch + sc); st.ks1 = *(const bf16x8*)(Kp + (r0_ + 32 + sr) * pitch + sc); } while (0)
#define SWRITE(bb, st) do { *(bf16x8*)(V_lds + (bb) * SHM_V + vst0) = st.vs0; *(bf16x8*)(V_lds + (bb) * SHM_V + vst1) = st.vs1; const int kc_ = sc * 2; \
    *(bf16x8*)(K_lds + (bb) * SHM_K + KSWZ(sr, kc_)) = st.ks0; *(bf16x8*)(K_lds + (bb) * SHM_K + KSWZ(32 + sr, kc_)) = st.ks1; } while (0)
  if (nt <= 0) return;
  SLOAD(sA, list[0]); if (nt > 1) SLOAD(sB, list[1]);
  SWRITE(0, sA); __syncthreads();
#define TILE_BODY(i, SFREE, SNEXT) do { const int j = list[i]; const int buf = (i) & 1; \
    if ((i) + 2 < nt) SLOAD(SFREE, list[(i) + 2]); \
    SBAR(); \
    tile_math(j, buf); \
    SBAR(); \
    if ((i) + 1 < nt) SWRITE(buf ^ 1, SNEXT); \
    __syncthreads(); } while (0)
  auto tile_math = [&](const int j, const int buf) __attribute__((always_inline)) {
    f32x16 p0, p1;
    qkt(p0, p1, K_lds + buf * SHM_K, qr, r32, hi);
    int klo = 0, khi = 63;
    if (MODE <= 1) { int nmax = (t0 + tk - 31) >> 4; nmax = nmax > 254 ? 254 : nmax; khi = nmax - 64 * j; }
    else if (MODE == 2) { const unsigned bit = (j < 32) ? ((sel_lo >> j) & 1u) : ((sel_hi >> (j - 32)) & 1u); khi = bit ? ((j == c) ? tk : 63) : -1; }
    else { khi = (j == c) ? tk : 63; klo = (j == c - 8) ? tk + 1 : 0; }
    if (__any(klo > 0 || khi < 63)) { const int klo2 = klo - 4 * hi, khi2 = khi - 4 * hi;
#pragma unroll
      for (int r = 0; r < 16; ++r) { const int kc = (r & 3) + 8 * (r >> 2);
        p0[r] = (kc >= klo2 && kc <= khi2) ? p0[r] : -INFINITY; p1[r] = (kc + 32 >= klo2 && kc + 32 <= khi2) ? p1[r] : -INFINITY; }
    }
    if (MODE != 1) {
      float pmax = p0[0];
#pragma unroll
      for (int r = 1; r < 16; ++r) pmax = fmaxf(pmax, p0[r]);
#pragma unroll
      for (int r = 0; r < 16; ++r) pmax = fmaxf(pmax, p1[r]);
      pmax = half_max(pmax);
      const float mn = fmaxf(m_reg, pmax); const float alpha = __builtin_amdgcn_exp2f((m_reg - mn) * C2); m_reg = mn;
      const float mnC = -mn * C2; float ps = 0.f;
#pragma unroll
      for (int r = 0; r < 16; ++r) { p0[r] = __builtin_amdgcn_exp2f(fmaf(p0[r], C2, mnC)); p1[r] = __builtin_amdgcn_exp2f(fmaf(p1[r], C2, mnC)); ps += p0[r] + p1[r]; }
      ps = half_sum(ps); l_reg = l_reg * alpha + ps;
      if (MODE >= 2) {
        if (__any(alpha < 1.f)) { if (hi == 0) al_l[r32] = alpha; asm volatile("s_waitcnt lgkmcnt(0)" ::: "memory");
#pragma unroll
          for (int d = 0; d < 4; ++d)
#pragma unroll
            for (int r = 0; r < 16; ++r) o[d][r] *= al_l[crow(r, hi)];
          asm volatile("s_waitcnt lgkmcnt(0)" ::: "memory"); }
      }
    } else {
      const float mnC = -m_reg * C2;
#pragma unroll
      for (int r = 0; r < 16; ++r) { p0[r] = __builtin_amdgcn_exp2f(fmaf(p0[r], C2, mnC)) * inv_l; p1[r] = __builtin_amdgcn_exp2f(fmaf(p1[r], C2, mnC)) * inv_l; }
#pragma unroll
      for (int q4 = 0; q4 < 4; ++q4) {
        float Ga = 2.f * (p0[4 * q4] + p0[4 * q4 + 1] + p0[4 * q4 + 2]) + p0[4 * q4 + 3], Ea = p0[4 * q4 + 3];
        float Gb = 2.f * (p1[4 * q4] + p1[4 * q4 + 1] + p1[4 * q4 + 2]) + p1[4 * q4 + 3], Eb = p1[4 * q4 + 3];
        Ga += qx1(Ga); Ga += qx2(Ga); Ea += qx1(Ea); Ea += qx2(Ea);
        Gb += qx1(Gb); Gb += qx2(Gb); Eb += qx1(Eb); Eb += qx2(Eb);
        if ((r32 & 3) == 0) { const int jl = 16 * j + 2 * q4 + hi; impG[tk * 64 + jl] = Ga; impE[tk * 64 + jl] = Ea; impG[tk * 64 + jl + 8] = Gb; impE[tk * 64 + jl + 8] = Eb; }
      }
#pragma unroll
      for (int r = 0; r < 16; ++r) { p0[r] *= gate0; p1[r] *= gate0; }
    }
    if (MODE >= 1) {
      bf16x8 pa0, pa1, pa2, pa3;
      PK4(p0, 0, pa0); PK4(p0, 8, pa1); PK4(p1, 0, pa2); PK4(p1, 8, pa3);
      SBAR();
      pv_d0(o, vb0 + buf * SHM_V, pa0, pa1, pa2, pa3);
    }
  };
  for (int i = 0; i < nt; i += 2) { TILE_BODY(i, sA, sB); if (i + 1 < nt) TILE_BODY(i + 1, sB, sA); }
#undef TILE_BODY
#undef SLOAD
#undef SWRITE
}
template <int MODE>
__device__ __forceinline__ void run_branch_pipe(char* lds, const bf16_t* __restrict__ Kp, const bf16_t* __restrict__ Vp, const int pitch, const int* list, const int nt,
                                                const bf16x8 (&qr)[8], f32x16 (&o)[4], float& m_reg, float& l_reg, const int c, const int tk,
                                                const unsigned sel_lo, const unsigned sel_hi) {
  int tid_ = threadIdx.x; asm volatile("" : "+v"(tid_));
  const int tid = tid_, wid = tid >> 6, lane = tid & 63, r32 = lane & 31, hi = lane >> 5;
  char* V_lds = lds + L_V; char* K_lds = lds + L_K;
  float* al_l = (float*)(lds + L_WSF) + wid * 64 + 32;
  const int sr = tid >> 4, sc = (tid & 15) * 8, vst0 = v_st(sr, sc), vst1 = v_st(32 + sr, sc);
  const int vb0 = (int)(uintptr_t)V_lds + v_rd_base(lane);
  Stg st;
#define SLOAD(jj) do { const size_t r0_ = (size_t)(jj) * 64; st.vs0 = *(const bf16x8*)(Vp + (r0_ + sr) * pitch + sc); st.vs1 = *(const bf16x8*)(Vp + (r0_ + 32 + sr) * pitch + sc); \
    st.ks0 = *(const bf16x8*)(Kp + (r0_ + sr) * pitch + sc); st.ks1 = *(const bf16x8*)(Kp + (r0_ + 32 + sr) * pitch + sc); } while (0)
#define SWRITE(bb) do { *(bf16x8*)(V_lds + (bb) * SHM_V + vst0) = st.vs0; *(bf16x8*)(V_lds + (bb) * SHM_V + vst1) = st.vs1; const int kc_ = sc * 2; \
    *(bf16x8*)(K_lds + (bb) * SHM_K + KSWZ(sr, kc_)) = st.ks0; *(bf16x8*)(K_lds + (bb) * SHM_K + KSWZ(32 + sr, kc_)) = st.ks1; } while (0)
#define MASK_PART(P0, P1, jt, AL) do { int klo_ = 0, khi_ = 63; bool lsel_ = true; \
    if (MODE == 2) { const unsigned bit_ = ((jt) < 32) ? ((sel_lo >> (jt)) & 1u) : ((sel_hi >> (((jt) - 32) & 31)) & 1u); lsel_ = (bit_ != 0u) && !((jt) & 64); khi_ = ((jt) == c) ? tk : 63; } \
    else { khi_ = ((jt) == c) ? tk : 63; klo_ = ((jt) == c - 8) ? tk + 1 : 0; if ((jt) & 64) khi_ = -1; } \
    if (__any(klo_ > 0 || khi_ < 63)) { const int klo2_ = klo_ - 4 * hi, khi2_ = khi_ - 4 * hi; \
      _Pragma("unroll") for (int r = 0; r < 16; ++r) { const int kc = (r & 3) + 8 * (r >> 2); \
        P0[r] = (kc >= klo2_ && kc <= khi2_) ? P0[r] : -INFINITY; P1[r] = (kc + 32 >= klo2_ && kc + 32 <= khi2_) ? P1[r] : -INFINITY; } } \
    float pmax_ = P0[0]; _Pragma("unroll") for (int r = 1; r < 16; ++r) pmax_ = fmaxf(pmax_, P0[r]); _Pragma("unroll") for (int r = 0; r < 16; ++r) pmax_ = fmaxf(pmax_, P1[r]); \
    pmax_ = half_max(pmax_); if (MODE == 2) pmax_ = lsel_ ? pmax_ : -INFINITY;     \
    float mn_ = m_reg; AL = 1.f; \
    if (!__all(pmax_ - m_reg <= 8.f / ATT_SCALE)) { mn_ = fmaxf(m_reg, pmax_); AL = __builtin_amdgcn_exp2f((m_reg - mn_) * C2); m_reg = mn_; }     \
    float mnC_ = -mn_ * C2; if (MODE == 2) mnC_ = lsel_ ? mnC_ : -INFINITY; \
    _Pragma("unroll") for (int r = 0; r < 16; ++r) { P0[r] = fmaf(P0[r], C2, mnC_); P1[r] = fmaf(P1[r], C2, mnC_); } \
    _Pragma("unroll") for (int r = 0; r < 16; ++r) P0[r] = __builtin_amdgcn_exp2f(P0[r]); } while (0)
#define FINISH(P0, P1, AL) do { _Pragma("unroll") for (int r = 0; r < 16; ++r) P1[r] = __builtin_amdgcn_exp2f(P1[r]); \
    float ps_ = 0.f; _Pragma("unroll") for (int r = 0; r < 16; ++r) ps_ += P0[r]; _Pragma("unroll") for (int r = 0; r < 16; ++r) ps_ += P1[r]; \
    ps_ = half_sum(ps_); l_reg = l_reg * AL + ps_; PK4(P0, 0, pa0); PK4(P0, 8, pa1); PK4(P1, 0, pa2); PK4(P1, 8, pa3); } while (0)
#define RESC(AL) do { if (__any((AL) < 1.f)) { if (hi == 0) al_l[r32] = (AL); asm volatile("s_waitcnt lgkmcnt(0)" ::: "memory"); \
    _Pragma("unroll") for (int d = 0; d < 4; ++d) _Pragma("unroll") for (int r = 0; r < 16; ++r) o[d][r] *= al_l[crow(r, hi)]; asm volatile("s_waitcnt lgkmcnt(0)" ::: "memory"); } } while (0)
  f32x16 pA0, pA1, pB0, pB1; float alA = 1.f, alB = 1.f; bf16x8 pa0, pa1, pa2, pa3;
  SLOAD(list[0] & 63); SWRITE(0); __syncthreads();
  SLOAD(list[1] & 63);
  qkt(pA0, pA1, K_lds, qr, r32, hi); { const int j0_ = list[0]; MASK_PART(pA0, pA1, j0_, alA); }
  SWRITE(1);
  __syncthreads();
  for (int i = 1; i + 1 < nt; i += 2) {
    { const int jt = list[i];
      SBAR(); qkt(pB0, pB1, K_lds + SHM_K, qr, r32, hi);
      FINISH(pA0, pA1, alA); SBAR();
      SLOAD(list[i + 1] & 63); SBAR();
      pv_d0(o, vb0, pa0, pa1, pa2, pa3); MASK_PART(pB0, pB1, jt, alB);
      __syncthreads(); SWRITE(0); RESC(alB); __syncthreads(); }
    { const int jt = list[i + 1];
      SBAR(); qkt(pA0, pA1, K_lds, qr, r32, hi);
      FINISH(pB0, pB1, alB); SBAR();
      SLOAD(list[i + 2] & 63); SBAR();
      pv_d0(o, vb0 + SHM_V, pa0, pa1, pa2, pa3); MASK_PART(pA0, pA1, jt, alA);
      __syncthreads(); SWRITE(1); RESC(alA); __syncthreads(); }
  }
  { const int jt = list[nt - 1];
    SBAR(); qkt(pB0, pB1, K_lds + SHM_K, qr, r32, hi);
    FINISH(pA0, pA1, alA); SBAR();
    pv_d0(o, vb0, pa0, pa1, pa2, pa3); MASK_PART(pB0, pB1, jt, alB);
    __syncthreads(); RESC(alB);
    FINISH(pB0, pB1, alB); SBAR();
    pv_d0(o, vb0 + SHM_V, pa0, pa1, pa2, pa3); }
  __syncthreads();
#undef SLOAD
#undef SWRITE
#undef MASK_PART
#undef FINISH
#undef RESC
}
__device__ __forceinline__ void scale_rows(f32x16 (&o)[4], float f, float* wsf, int r32, int hi) {
  if (hi == 0) wsf[r32] = f; asm volatile("s_waitcnt lgkmcnt(0)" ::: "memory");
#pragma unroll
  for (int r = 0; r < 16; ++r) { const float fr = wsf[crow(r, hi)];
#pragma unroll
    for (int d = 0; d < 4; ++d) o[d][r] *= fr; }
  asm volatile("s_waitcnt lgkmcnt(0)" ::: "memory");
}
__device__ __forceinline__ void park_store(const f32x16 (&o)[4], char* lds, int tid) {
#pragma unroll
  for (int k = 0; k < 8; ++k) { const int d = k >> 1, rb = (k & 1) * 8;
    u32x4 w = {cvtpk(o[d][rb], o[d][rb + 1]), cvtpk(o[d][rb + 2], o[d][rb + 3]), cvtpk(o[d][rb + 4], o[d][rb + 5]), cvtpk(o[d][rb + 6], o[d][rb + 7])};
    *(u32x4*)(lds + L_OACC + k * 8192 + tid * 16) = w; }
}
__device__ __forceinline__ void park_add(f32x16 (&o)[4], const char* lds, int tid) {
#pragma unroll
  for (int k = 0; k < 8; ++k) { const int d = k >> 1, rb = (k & 1) * 8; const u32x4 w = *(const u32x4*)(lds + L_OACC + k * 8192 + tid * 16);
    o[d][rb] += __uint_as_float(w.x << 16); o[d][rb + 1] += __uint_as_float(w.x & 0xffff0000u); o[d][rb + 2] += __uint_as_float(w.y << 16); o[d][rb + 3] += __uint_as_float(w.y & 0xffff0000u);
    o[d][rb + 4] += __uint_as_float(w.z << 16); o[d][rb + 5] += __uint_as_float(w.z & 0xffff0000u); o[d][rb + 6] += __uint_as_float(w.w << 16); o[d][rb + 7] += __uint_as_float(w.w & 0xffff0000u); }
}

__device__ __forceinline__ void nsa_unit(unsigned char* ws, unsigned char* Y8, char* lds, const int b, const int g, const int c, const int skip = 0) {
  int tid_ = threadIdx.x; asm volatile("" : "+v"(tid_));
  const int tid = tid_, wid = tid >> 6, lane = tid & 63, r32 = lane & 31, hi = lane >> 5;
  const int t0 = c * 64, tk = wid * 8 + (r32 >> 2), hh = r32 & 3, head = g * 4 + hh;
  const size_t rowq = (size_t)b * SEQ + t0 + tk;
  bf16_t* QY = (bf16_t*)(ws + WS_QY); const bf16_t* KVb = (const bf16_t*)(ws + WS_KV) + (size_t)b * SEQ * 3072 + g * 128;
  const bf16_t* KC = (const bf16_t*)(ws + WS_KC) + (size_t)(b * 4 + g) * 256 * 128; const bf16_t* VC = (const bf16_t*)(ws + WS_VC) + (size_t)(b * 4 + g) * 256 * 128;
  float* wsf = (float*)(lds + L_WSF) + wid * 64;
  float* impG = (float*)(lds + L_IMPG); float* impE = (float*)(lds + L_IMPE); float* impF = (float*)(lds + L_IMPF);
  unsigned* selm = (unsigned*)(lds + L_SEL); int* lists = (int*)(lds + L_LIST);
  bf16x8 qr[8];
  { const bf16_t* Qw = QY + rowq * 2048 + head * 128 + hi * 8;
#pragma unroll
    for (int d0 = 0; d0 < 8; ++d0) qr[d0] = *(const bf16x8*)(Qw + d0 * 16); }
  float* gl = (float*)(lds + L_GATE) + wid * 96;
  if (hi == 0) { const float* gp = (const float*)(ws + WS_SMB) + rowq * 64 + head * 3; constexpr size_t SLAB = (size_t)T * 64;
#pragma unroll
    for (int k = 0; k < 3; ++k) gl[32 * k + r32] = sigm(((gp[k] + gp[SLAB + k]) + gp[2 * SLAB + k]) + gp[3 * SLAB + k]); }
#define GATE(k) gl[32 * (k) + r32]
  const int nvalid = (4 * c + 3 > 255) ? 255 : 4 * c + 3; const int ntc = (nvalid + 63) >> 6;
  if (tid < 4) lists[tid] = tid;
  __syncthreads();
  f32x16 o[4]; o[0] = f32x16{}; o[1] = f32x16{}; o[2] = f32x16{}; o[3] = f32x16{};
  float m_reg = -1e30f, l_reg = 0.f;
  if (!((skip >> 9) & 1)) run_branch<0>(lds, KC, VC, 128, lists, ntc, qr, o, m_reg, l_reg, c, tk, t0, 0u, 0u, 0.f, 0.f);
  if (!((skip >> 9) & 1)) { const float inv_l = l_reg > 0.f ? 1.f / l_reg : 0.f;
    const float g0 = GATE(0);
    run_branch<1>(lds, KC, VC, 128, lists, ntc, qr, o, m_reg, l_reg, c, tk, t0, 0u, 0u, inv_l, g0); }
  { const int stk = tid >> 3, part = tid & 7;
#pragma unroll
    for (int jj = 0; jj < 8; ++jj) { const int j = part * 8 + jj; float v = impG[stk * 64 + j] + (j > 0 ? impE[stk * 64 + j - 1] : 0.f);
      const bool forced = (j == 0) || (j == c) || (j == c - 1); v = forced ? 1e9f : (j > c ? -1e9f : v);
      const int u_ = __float_as_int(v); ((int*)impF)[stk * 64 + j] = ((u_ ^ ((u_ >> 31) & 0x7fffffff)) & ~63) | (63 - j); }
    __syncthreads();
    unsigned mybits = 0;
    { const int* kf = (const int*)impF + stk * 64; int kj[8], rank[8];
#pragma unroll
      for (int jj = 0; jj < 8; ++jj) { kj[jj] = kf[part * 8 + jj]; rank[jj] = 0; }
#pragma unroll
      for (int i4 = 0; i4 < 16; ++i4) { const u32x4 uu = *(const u32x4*)(kf + 4 * i4);
#pragma unroll
        for (int jj = 0; jj < 8; ++jj) rank[jj] += ((int)uu.x > kj[jj] ? 1 : 0) + ((int)uu.y > kj[jj] ? 1 : 0) + ((int)uu.z > kj[jj] ? 1 : 0) + ((int)uu.w > kj[jj] ? 1 : 0); }
#pragma unroll
      for (int jj = 0; jj < 8; ++jj) if (rank[jj] < 16) mybits |= 1u << jj; }
    unsigned lo = 0, hi_ = 0;
#pragma unroll
    for (int pp = 0; pp < 8; ++pp) { const unsigned bb = __shfl(mybits, (lane & ~7) + pp); if (pp < 4) lo |= bb << (8 * pp); else hi_ |= bb << (8 * (pp - 4)); }
    if (part == 0) { selm[stk * 2] = lo; selm[stk * 2 + 1] = hi_; }
    __syncthreads();
    if (wid == 0) { unsigned ulo = selm[lane * 2], uhi = selm[lane * 2 + 1];
#pragma unroll
      for (int off = 32; off >= 1; off >>= 1) { ulo |= __shfl_xor(ulo, off); uhi |= __shfl_xor(uhi, off); }
      { const bool bit = (lane <= c) && (((lane < 32) ? (ulo >> lane) : (uhi >> (lane - 32))) & 1u); const unsigned long long bal = __ballot(bit);
        const int n = __popcll(bal); const int pos = (int)__builtin_amdgcn_mbcnt_hi((unsigned)(bal >> 32), __builtin_amdgcn_mbcnt_lo((unsigned)bal, 0u));
        if (bit) lists[4 + pos] = lane;
        if (lane == 0) { int nn = n; if (n & 1) { lists[4 + n] = (63 - __builtin_clzll(bal)) | 64; ++nn; } lists[84] = nn; }
        const int w0 = (c > 8 ? c - 8 : 0), n2 = c - w0 + 1;
        if (lane < n2) lists[68 + lane] = w0 + lane;
        if (lane == 0) { int nn2 = n2; if (n2 & 1) { lists[68 + n2] = c | 64; ++nn2; } lists[85] = nn2; } } }
    __syncthreads();
  }
  const unsigned sel_lo = selm[tk * 2], sel_hi = selm[tk * 2 + 1];
  const int n_slc = lists[84], n_win = lists[85];
  park_store(o, lds, tid);
  o[0] = f32x16{}; o[1] = f32x16{}; o[2] = f32x16{}; o[3] = f32x16{}; m_reg = -1e30f; l_reg = 0.f;
  if (!((skip >> 11) & 1)) run_branch_pipe<2>(lds, KVb + 1024, KVb + 1536, 3072, lists + 4, n_slc, qr, o, m_reg, l_reg, c, tk, sel_lo, sel_hi);
  { const float g1 = GATE(1); scale_rows(o, l_reg > 0.f ? g1 / l_reg : 0.f, wsf, r32, hi); }
  park_add(o, lds, tid); park_store(o, lds, tid);
  o[0] = f32x16{}; o[1] = f32x16{}; o[2] = f32x16{}; o[3] = f32x16{}; m_reg = -1e30f; l_reg = 0.f;
  if (!((skip >> 12) & 1)) run_branch_pipe<3>(lds, KVb + 2048, KVb + 2560, 3072, lists + 68, n_win, qr, o, m_reg, l_reg, c, tk, 0u, 0u);
  { const float g2 = GATE(2); scale_rows(o, l_reg > 0.f ? g2 / l_reg : 0.f, wsf, r32, hi); }
#undef GATE
  park_add(o, lds, tid);
  __syncthreads();
  { int ln_ = lane; asm volatile("" : "+v"(ln_));
    bf16_t* yt = (bf16_t*)(lds + L_OACC) + wid * (32 * 136);
#pragma unroll
    for (int r = 0; r < 16; ++r) { const int row = crow(r, hi);
#pragma unroll
      for (int d0 = 0; d0 < 4; ++d0) yt[row * 136 + d0 * 32 + r32] = f2bf(o[d0][r]); }
    asm volatile("s_waitcnt lgkmcnt(0)" ::: "memory");
#pragma unroll
    for (int k = 0; k < 8; ++k) { const int id = ln_ + 64 * k, row = id >> 4, ch = id & 15; const int tkr = wid * 8 + (row >> 2), hr = row & 3;
      *(unsigned long long*)(Y8 + ((size_t)b * SEQ + t0 + tkr) * 3072 + 1024 + (g * 4 + hr) * 128 + 8 * ch) = pg8::bf8_to_f8(*(const pg8::bf16x8*)(yt + row * 136 + 8 * ch), 8.f); } }
  __syncthreads();
}
#undef PK4
#undef KSWZ
#undef SBAR
}

namespace cmpu {
using bf16x8 = __attribute__((ext_vector_type(8))) short;
using f32x4  = __attribute__((ext_vector_type(4))) float;
constexpr int NTOK = 528, HID_PITCH = 136, L_TOK = 0, L_HID = NTOK * 256;
static_assert(L_HID + 32 * HID_PITCH * 2 <= 147456 - 64, "compress LDS map");
__device__ __forceinline__ void cmp_unit(unsigned char* ws, char* lds, const int which, const int bg, const int nb2) {
  int tid_ = threadIdx.x; asm volatile("" : "+v"(tid_));
  const int tid = tid_, lane = tid & 63, i = lane & 15, gq = lane >> 4; const int w = __builtin_amdgcn_readfirstlane(tid >> 6);
  const int b = bg >> 2, g = bg & 3;
  bf16_t* hid = (bf16_t*)(lds + L_HID);
  const bf16_t* KV = (const bf16_t*)(ws + WS_KV); const float* tab = (const float*)(ws + WS_ROPE);
  const bf16_t* W1T = (const bf16_t*)(ws + WS_W1T + (which ? MiB : 0)); const bf16_t* W2T = (const bf16_t*)(ws + WS_SMALL + (which ? 128 : 64) * 1024);
  const float* bias = (const float*)(ws + WS_SMALL) + which * 128;
  const bf16_t* Bp = W1T + (size_t)(16 * w + i) * 4096 + 8 * gq;
  f32x4 acc0 = {0.f, 0.f, 0.f, 0.f}, acc1 = {0.f, 0.f, 0.f, 0.f};
  bf16x8 wA[16], wB[16];
#define CMP_LOAD(l0, B) do { _Pragma("unroll") for (int j_ = 0; j_ < 4; ++j_) _Pragma("unroll") for (int ks_ = 0; ks_ < 4; ++ks_) B[4 * j_ + ks_] = *(const bf16x8*)(Bp + ((l0) + j_) * 128 + 32 * ks_); } while (0)
#define CMP_COMP(l0, B) do { _Pragma("unroll") for (int j_ = 0; j_ < 4; ++j_) { const int l_ = (l0) + j_; const int s0 = (l_ & 15) * 33 + i + (l_ >> 4), s1 = s0 + 16; \
    _Pragma("unroll") for (int ks_ = 0; ks_ < 4; ++ks_) { const int cx = 4 * ks_ + gq; \
      const bf16x8 a0 = *(const bf16x8*)(lds + L_TOK + s0 * 256 + ((cx ^ (s0 & 7)) << 4)), a1 = *(const bf16x8*)(lds + L_TOK + s1 * 256 + ((cx ^ (s1 & 7)) << 4)); \
      acc0 = __builtin_amdgcn_mfma_f32_16x16x32_bf16(a0, B[4 * j_ + ks_], acc0, 0, 0, 0); acc1 = __builtin_amdgcn_mfma_f32_16x16x32_bf16(a1, B[4 * j_ + ks_], acc1, 0, 0, 0); } } } while (0)
  CMP_LOAD(0, wA); CMP_LOAD(4, wB);
  __builtin_amdgcn_sched_barrier(0);
  for (int ch = tid; ch < NTOK * 16; ch += 512) { const int tl = ch >> 4, cx = ch & 15, c8 = cx * 8; const int tg = 512 * nb2 + tl;
    bf16x8 v = bf16x8{};
    if (tg < SEQ) { const size_t trow = (size_t)b * SEQ + tg; const bf16_t* src = KV + trow * 3072 + which * 512 + g * 128;
      v = *(const bf16x8*)(src + c8);
      if (which == 0 && c8 < 32) { const bf16x8 vp = *(const bf16x8*)(src + (c8 ^ 16)); const float* tb = tab + (trow * 16 + (c8 & 15)) * 2;
#pragma unroll
        for (int e = 0; e < 8; ++e) { const float cs = tb[2 * e], sn = tb[2 * e + 1]; const float a = bf2f((bf16_t)v[e]), p = bf2f((bf16_t)vp[e]);
          const float r = (c8 < 16) ? (a * cs - p * sn) : (a * cs + p * sn); v[e] = (short)f2bf(r); } } }
    const int slot = (tl & 15) * 33 + (tl >> 4);
    *(bf16x8*)(lds + L_TOK + slot * 256 + ((cx ^ (slot & 7)) << 4)) = v; }
  __syncthreads();
#pragma unroll
  for (int it = 0; it < 4; ++it) {
    __builtin_amdgcn_sched_barrier(0);
    CMP_COMP(8 * it, wA);
    __builtin_amdgcn_sched_barrier(0);
    if (it < 3) CMP_LOAD(8 * it + 8, wA);
    __builtin_amdgcn_sched_barrier(0);
    CMP_COMP(8 * it + 4, wB);
    __builtin_amdgcn_sched_barrier(0);
    if (it < 3) CMP_LOAD(8 * it + 12, wB);
    __builtin_amdgcn_sched_barrier(0); }
#undef CMP_LOAD
#undef CMP_COMP
  { const float bs = bias[16 * w + i];
#pragma unroll
    for (int r = 0; r < 4; ++r) { hid[(4 * gq + r) * HID_PITCH + 16 * w + i] = f2bf(gelu_tanh(acc0[r] + bs)); hid[(16 + 4 * gq + r) * HID_PITCH + 16 * w + i] = f2bf(gelu_tanh(acc1[r] + bs)); } }
  __syncthreads();
  f32x4 o0 = {0.f, 0.f, 0.f, 0.f}, o1 = {0.f, 0.f, 0.f, 0.f};
#pragma unroll
  for (int ks = 0; ks < 4; ++ks) { const bf16x8 bv = *(const bf16x8*)(W2T + (16 * w + i) * 128 + 32 * ks + 8 * gq);
    const bf16x8 a0 = *(const bf16x8*)(hid + i * HID_PITCH + 32 * ks + 8 * gq), a1 = *(const bf16x8*)(hid + (16 + i) * HID_PITCH + 32 * ks + 8 * gq);
    o0 = __builtin_amdgcn_mfma_f32_16x16x32_bf16(a0, bv, o0, 0, 0, 0); o1 = __builtin_amdgcn_mfma_f32_16x16x32_bf16(a1, bv, o1, 0, 0, 0); }
  bf16_t* outp = (bf16_t*)(ws + (which ? WS_VC : WS_KC)) + (size_t)bg * 256 * 128;
#pragma unroll
  for (int r = 0; r < 4; ++r) { const int n0 = 32 * nb2 + 4 * gq + r, n1 = n0 + 16;
    outp[(size_t)n0 * 128 + 16 * w + i] = f2bf(o0[r]); outp[(size_t)n1 * 128 + 16 * w + i] = (n1 == 255) ? (bf16_t)0 : f2bf(o1[r]); }
  __syncthreads();
}
}


namespace peer {
using bf16x8 = __attribute__((ext_vector_type(8))) short;
using f32x4  = __attribute__((ext_vector_type(4))) float;
typedef unsigned u32x4 __attribute__((ext_vector_type(4)));
typedef __bf16 bf16x2_t __attribute__((ext_vector_type(2)));
constexpr int PEP = 132;
constexpr int L_PE = 0, L_PW = 64 * PEP * 4, L_H2S = 2 * 64 * PEP * 4, L_RS = L_H2S + 32768, L_END = L_RS + 256;
constexpr int NSLICE = 16;
__device__ __forceinline__ int sortable(float f) { const int u = __float_as_int(f); return u ^ ((u >> 31) & 0x7fffffff); }
__device__ __forceinline__ float unsortable(int k) { return __int_as_float(k ^ ((k >> 31) & 0x7fffffff)); }
__device__ __forceinline__ float dot2(unsigned a, unsigned b, float c) { return __builtin_amdgcn_fdot2_f32_bf16(__builtin_bit_cast(bf16x2_t, a), __builtin_bit_cast(bf16x2_t, b), c, false); }
__device__ __forceinline__ float bflo(unsigned w) { return __uint_as_float(w << 16); }
__device__ __forceinline__ float bfhi(unsigned w) { return __uint_as_float(w & 0xffff0000u); }
__device__ __forceinline__ void topk_half(const float* __restrict__ qtile, const float* __restrict__ sk, float* kbuf, const int lane, int (&list)[16]) {
  const int i = lane & 15, gq = lane >> 4;
#define SPLIT8(src, o, H, L) do { unsigned h_[4], l_[4]; _Pragma("unroll") for (int e_ = 0; e_ < 4; ++e_) { const float x0_ = src[(o) + 2 * e_], x1_ = src[(o) + 2 * e_ + 1]; h_[e_] = att::cvtpk(x0_, x1_); \
      l_[e_] = att::cvtpk(x0_ - bflo(h_[e_]), x1_ - bfhi(h_[e_])); } H = __builtin_bit_cast(bf16x8, (u32x4){h_[0], h_[1], h_[2], h_[3]}); L = __builtin_bit_cast(bf16x8, (u32x4){l_[0], l_[1], l_[2], l_[3]}); } while (0)
  bf16x8 bqh[4][2], bql[4][2];
#pragma unroll
  for (int tt = 0; tt < 4; ++tt) { const float* qp_ = qtile + (size_t)(16 * tt + i) * 1024 + 16 * gq; float qf[16];
#pragma unroll
    for (int u = 0; u < 4; ++u) { const f32x4 v = *(const f32x4*)(qp_ + 4 * u); qf[4 * u] = v[0]; qf[4 * u + 1] = v[1]; qf[4 * u + 2] = v[2]; qf[4 * u + 3] = v[3]; }
    SPLIT8(qf, 0, bqh[tt][0], bql[tt][0]); SPLIT8(qf, 8, bqh[tt][1], bql[tt][1]); }
#pragma unroll
  for (int k = 0; k < 16; ++k) list[k] = (int)0x80000000;
  float an[16];
  { const float* sp = sk + (size_t)i * 64 + 16 * gq;
#pragma unroll
    for (int u = 0; u < 4; ++u) { const f32x4 v = *(const f32x4*)(sp + 4 * u); an[4 * u] = v[0]; an[4 * u + 1] = v[1]; an[4 * u + 2] = v[2]; an[4 * u + 3] = v[3]; } }
#pragma unroll 2
  for (int nt = 0; nt < 8; ++nt) {
    bf16x8 akh[2], akl[2];
    SPLIT8(an, 0, akh[0], akl[0]); SPLIT8(an, 8, akh[1], akl[1]);
    if (nt < 7) { const float* sp = sk + (size_t)(16 * (nt + 1) + i) * 64 + 16 * gq;
#pragma unroll
      for (int u = 0; u < 4; ++u) { const f32x4 v = *(const f32x4*)(sp + 4 * u); an[4 * u] = v[0]; an[4 * u + 1] = v[1]; an[4 * u + 2] = v[2]; an[4 * u + 3] = v[3]; } }
    f32x4 cacc[4];
#pragma unroll
    for (int tt = 0; tt < 4; ++tt) cacc[tt] = (f32x4){0.f, 0.f, 0.f, 0.f};
#pragma unroll
    for (int s2 = 0; s2 < 2; ++s2)
#pragma unroll
      for (int tt = 0; tt < 4; ++tt) { cacc[tt] = __builtin_amdgcn_mfma_f32_16x16x32_bf16(akl[s2], bqh[tt][s2], cacc[tt], 0, 0, 0); cacc[tt] = __builtin_amdgcn_mfma_f32_16x16x32_bf16(akh[s2], bql[tt][s2], cacc[tt], 0, 0, 0);
        cacc[tt] = __builtin_amdgcn_mfma_f32_16x16x32_bf16(akh[s2], bqh[tt][s2], cacc[tt], 0, 0, 0); }
#pragma unroll
    for (int tt = 0; tt < 4; ++tt)
#pragma unroll
      for (int r = 0; r < 4; ++r) kbuf[(4 * gq + r) * 64 + 16 * tt + i] = cacc[tt][r];
    asm volatile("s_waitcnt lgkmcnt(0)" ::: "memory");
    float sc[16];
#pragma unroll
    for (int nn = 0; nn < 16; ++nn) sc[nn] = kbuf[nn * 64 + lane];
    asm volatile("s_waitcnt lgkmcnt(0)" ::: "memory");
    int cn[16];
#pragma unroll
    for (int nn = 0; nn < 16; ++nn) cn[nn] = (sortable(sc[nn]) & ~127) | (127 - (nt * 16 + nn));
#define CE(a_, b_) do { const int hi_ = max(cn[a_], cn[b_]); cn[b_] = min(cn[a_], cn[b_]); cn[a_] = hi_; } while (0)
    CE(0,1); CE(2,3); CE(0,2); CE(1,3); CE(1,2); CE(4,5); CE(6,7); CE(4,6); CE(5,7); CE(5,6); CE(0,4); CE(2,6); CE(2,4); CE(1,5); CE(3,7); CE(3,5); CE(1,2); CE(3,4); CE(5,6); CE(8,9); CE(10,11); CE(8,10); CE(9,11); CE(9,10); CE(12,13); CE(14,15); CE(12,14); CE(13,15); CE(13,14); CE(8,12); CE(10,14); CE(10,12); CE(9,13); CE(11,15); CE(11,13); CE(9,10); CE(11,12); CE(13,14); CE(0,8); CE(4,12); CE(4,8); CE(2,10); CE(6,14); CE(6,10); CE(2,4); CE(6,8); CE(10,12); CE(1,9); CE(5,13); CE(5,9); CE(3,11); CE(7,15); CE(7,11); CE(3,5); CE(7,9); CE(11,13); CE(1,2); CE(3,4); CE(5,6); CE(7,8); CE(9,10); CE(11,12); CE(13,14);
#undef CE
#pragma unroll
    for (int k = 0; k < 16; ++k) list[k] = max(list[k], cn[15 - k]);
#pragma unroll
    for (int j = 8; j > 0; j >>= 1)
#pragma unroll
      for (int i2 = 0; i2 < 16; ++i2) { const int l = i2 ^ j; if (l > i2) { const int a_ = list[i2], b_ = list[l]; list[i2] = max(a_, b_); list[l] = min(a_, b_); } }
  }
}
__device__ __forceinline__ void route_tile(unsigned char* ws, char* lds, const float* __restrict__ sk1, const float* __restrict__ sk2, const int tile) {
  int tid_ = threadIdx.x; asm volatile("" : "+v"(tid_));
  const int lane = tid_ & 63; const int h = __builtin_amdgcn_readfirstlane(tid_ >> 6);
  const size_t t = (size_t)tile * 64 + lane;
  const float* qtile = (const float*)(ws + WS_QP) + (size_t)tile * 64 * 1024 + h * 128;
  int l1[16], l2[16];
  float* kbuf = (float*)(lds + L_H2S) + h * 1024;
  topk_half(qtile, sk1 + (size_t)h * 128 * 64, kbuf, lane, l1);
  topk_half(qtile + 64, sk2 + (size_t)h * 128 * 64, kbuf, lane, l2);
  int* pe = (int*)(lds + L_PE) + lane * PEP + h * 16; float* pg = (float*)(lds + L_PW) + lane * PEP + h * 16;
#pragma unroll
  for (int k = 0; k < 16; ++k) { pe[k] = l1[k]; ((int*)pg)[k] = l2[k]; }
  int key[16];
  { float f1[16], f2[16];
#pragma unroll
    for (int k = 0; k < 16; ++k) { f1[k] = unsortable(l1[k] & ~127); f2[k] = unsortable(l2[k] & ~127); key[k] = (int)0x80000000; }
#pragma unroll
    for (int a = 0; a < 16; ++a)
#pragma unroll
      for (int b = 0; b < 16; ++b) if ((a + 1) * (b + 1) <= 16) { int x = (sortable(f1[a] + f2[b]) & ~255) | (255 - (16 * a + b));
#pragma unroll
        for (int k = (a + 1) * (b + 1) - 1; k < 16; ++k) { const int t_ = max(key[k], x); x = min(key[k], x); key[k] = t_; } } }
  asm volatile("s_waitcnt lgkmcnt(0)" ::: "memory");
  float vv[16]; int pp[16];
#pragma unroll
  for (int k = 0; k < 16; ++k) { const int pl = 255 - (key[k] & 255); const int la = pe[pl >> 4], lb = ((const int*)pg)[pl & 15];
    vv[k] = unsortable(la & ~127) + unsortable(lb & ~127); pp[k] = ((127 - (la & 127)) << 7) | (127 - (lb & 127)); }
  asm volatile("s_waitcnt lgkmcnt(0)" ::: "memory");
  const float vmax = vv[0]; float sum = 0.f;
#pragma unroll
  for (int k = 0; k < 16; ++k) { vv[k] = __expf(vv[k] - vmax); sum += vv[k]; }
  const float inv = 1.f / sum;
#pragma unroll
  for (int k = 0; k < 16; ++k) { pe[k] = pp[k]; pg[k] = vv[k] * inv; }
  if (h == 0) { const float* sp = (const float*)(ws + WS_W1T) + t * 32; float sq = 0.f;
#pragma unroll
    for (int k = 0; k < 8; ++k) { const f32x4 v = *(const f32x4*)(sp + 4 * k); sq += (v[0] + v[1]) + (v[2] + v[3]); }
    ((float*)(lds + L_RS))[lane] = rsqrtf(sq * (1.f / 2048.f) + EPS); }
}
typedef float f32x2_t __attribute__((ext_vector_type(2)));
#define FP8LO(wd) __builtin_amdgcn_cvt_pk_f32_fp8((int)(wd), false)
#define FP8HI(wd) __builtin_amdgcn_cvt_pk_f32_fp8((int)(wd), true)
__device__ __forceinline__ void up_pass(unsigned char* ws, char* lds, const float* __restrict__ g2, const int tile) {
  int tid_ = threadIdx.x; asm volatile("" : "+v"(tid_));
  const int tid = tid_, lane = tid & 63, g = lane >> 3, cc = lane & 7; const int w = __builtin_amdgcn_readfirstlane(tid >> 6);
  const int* PE = (const int*)(lds + L_PE) + (w * 8 + g) * PEP; float* PW = (float*)(lds + L_PW) + (w * 8 + g) * PEP; unsigned char* H2S8 = (unsigned char*)(lds + L_H2S); typedef unsigned u32x2q __attribute__((ext_vector_type(2)));
  const bf16_t* XB = (const bf16_t*)(ws + WS_XB) + ((size_t)tile * 64 + (tid >> 4)) * 2048 + 8 * (tid & 15);
  int acc[128];
#pragma unroll
  for (int j = 0; j < 128; ++j) acc[j] = 0;
#define Q8(v) (__float2int_rn(__builtin_amdgcn_fmed3f((v) * 15.875f, -127.f, 127.f)) & 255)
#define STAGE_H2(sig, buf) do { _Pragma("unroll") for (int hh_ = 0; hh_ < 2; ++hh_) { const u32x4 xv = *(const u32x4*)(XB + (size_t)hh_ * 32 * 2048 + 128 * (sig)); \
    const f32x4 ga = *(const f32x4*)(g2 + 128 * (sig) + 8 * (tid & 15)), gb = *(const f32x4*)(g2 + 128 * (sig) + 8 * (tid & 15) + 4); \
    u32x2q hv; hv.x = (unsigned)(Q8(bflo(xv.x) * ga[0]) | (Q8(bfhi(xv.x) * ga[1]) << 8) | (Q8(bflo(xv.y) * ga[2]) << 16) | (Q8(bfhi(xv.y) * ga[3]) << 24)); \
    hv.y = (unsigned)(Q8(bflo(xv.z) * gb[0]) | (Q8(bfhi(xv.z) * gb[1]) << 8) | (Q8(bflo(xv.w) * gb[2]) << 16) | (Q8(bfhi(xv.w) * gb[3]) << 24)); \
    *(u32x2q*)(H2S8 + (buf) * 8192 + ((tid >> 4) + 32 * hh_) * 128 + 8 * (tid & 15)) = hv; } } while (0)
  __syncthreads();
  STAGE_H2(0, 0);
  __syncthreads();
#define UP_LOAD(jb, B) do { _Pragma("unroll") for (int i_ = 0; i_ < 8; ++i_) { const unsigned e_ = (unsigned)PE[8 * (jb) + i_]; B[i_] = *(const u32x4*)(Us + ((e_ << 7) + lo16)); } } while (0)
#define UP_COMP(jb, B) do { _Pragma("unroll") for (int i_ = 0; i_ < 8; ++i_) { const u32x4 u_ = B[i_]; int t_ = acc[8 * (jb) + i_]; \
      t_ = __builtin_amdgcn_sdot4((int)u_.x, hq[0], t_, false); t_ = __builtin_amdgcn_sdot4((int)u_.y, hq[1], t_, false); t_ = __builtin_amdgcn_sdot4((int)u_.z, hq[2], t_, false); t_ = __builtin_amdgcn_sdot4((int)u_.w, hq[3], t_, false); \
      acc[8 * (jb) + i_] = t_; } } while (0)
  const unsigned lo16 = 16u * (unsigned)cc;
#pragma unroll 1
  for (int sig = 0; sig < NSLICE; ++sig) {
    const int buf = sig & 1;
    if (sig + 1 < NSLICE) STAGE_H2(sig + 1, buf ^ 1);
    const unsigned char* Us = ws + WS_UB + (size_t)sig * 16384 * 128;
    u32x4 bA[8], bB[8];
    UP_LOAD(0, bA); UP_LOAD(1, bB);
    int hq[4]; { const u32x4 hv4 = *(const u32x4*)(H2S8 + buf * 8192 + (w * 8 + g) * 128 + 16 * cc); hq[0] = (int)hv4.x; hq[1] = (int)hv4.y; hq[2] = (int)hv4.z; hq[3] = (int)hv4.w; }
#pragma unroll
    for (int jp = 0; jp < 8; ++jp) {
      __builtin_amdgcn_sched_barrier(0);
      UP_COMP(2 * jp, bA);
      __builtin_amdgcn_sched_barrier(0);
      if (jp < 7) UP_LOAD(2 * jp + 2, bA);
      __builtin_amdgcn_sched_barrier(0);
      UP_COMP(2 * jp + 1, bB);
      __builtin_amdgcn_sched_barrier(0);
      if (jp < 7) UP_LOAD(2 * jp + 3, bB);
      __builtin_amdgcn_sched_barrier(0); }
    __syncthreads();
  }
#undef UP_LOAD
#undef UP_COMP
#undef STAGE_H2
#undef Q8
  const float rs = ((const float*)(lds + L_RS))[w * 8 + g]; const float* SU = (const float*)(ws + WS_UB + 64 * MiB); const float* SV = SU + 16384;
  { const bool b4 = (cc & 4) != 0, b2 = (cc & 2) != 0, b1 = (cc & 1) != 0;
    float r4[64];
#pragma unroll
    for (int k = 0; k < 16; ++k)
#pragma unroll
      for (int t = 0; t < 4; ++t) { const float lo = (float)acc[8 * k + t], hi = (float)acc[8 * k + t + 4]; r4[4 * k + t] = (b4 ? hi : lo) + att::qm8(b4 ? lo : hi); }
    float r2[32];
#pragma unroll
    for (int k = 0; k < 16; ++k)
#pragma unroll
      for (int t = 0; t < 2; ++t) { const float lo = r4[4 * k + t], hi = r4[4 * k + t + 2]; r2[2 * k + t] = (b2 ? hi : lo) + att::qx2(b2 ? lo : hi); }
    float r1[16];
#pragma unroll
    for (int k = 0; k < 16; ++k) { const float lo = r2[2 * k], hi = r2[2 * k + 1]; r1[k] = (b1 ? hi : lo) + att::qx1(b1 ? lo : hi); }
    int ex[16]; float su[16], sv[16], pw[16];
#pragma unroll
    for (int k = 0; k < 16; ++k) { ex[k] = PE[8 * k + cc]; pw[k] = PW[8 * k + cc]; }
#pragma unroll
    for (int k = 0; k < 16; ++k) { su[k] = SU[ex[k]]; sv[k] = SV[ex[k]]; }
    float wv[16], wm = 0.f;
#pragma unroll
    for (int k = 0; k < 16; ++k) { const float x = r1[k] * (rs * (1.f / 15.875f)) * su[k]; const float u = 1.5957691216057308f * (x + 0.044715f * x * x * x);
      wv[k] = pw[k] * (x * __builtin_amdgcn_rcpf(1.f + __expf(-u))) * sv[k]; wm = fmaxf(wm, fabsf(wv[k])); }
    wm = fmaxf(wm, att::qx1(wm)); wm = fmaxf(wm, att::qx2(wm)); wm = fmaxf(wm, att::qm8(wm));
    const float qs = wm > 0.f ? 127.f / wm : 0.f;
    int* PEw = (int*)PE; int* PWQ = (int*)PW;
#pragma unroll
    for (int q = 0; q < 4; ++q) {
      *(att::u32x4*)(PEw + 16 * cc + 4 * q) = (att::u32x4){(unsigned)ex[4 * q], (unsigned)ex[4 * q + 1], (unsigned)ex[4 * q + 2], (unsigned)ex[4 * q + 3]};
      PWQ[4 * cc + q] = (__float2int_rn(wv[4 * q] * qs) & 255) | ((__float2int_rn(wv[4 * q + 1] * qs) & 255) << 8) | ((__float2int_rn(wv[4 * q + 2] * qs) & 255) << 16) | (__float2int_rn(wv[4 * q + 3] * qs) << 24); }
    if (cc == 0) ((float*)(lds + L_RS))[w * 8 + g] = wm * (1.f / 127.f);
  }
  __syncthreads();
}
__device__ __forceinline__ void down_pass(unsigned char* ws, char* lds, float* __restrict__ out, const float* __restrict__ fg, const int tile) {
  int tid_ = threadIdx.x; asm volatile("" : "+v"(tid_));
  const int tid = tid_, lane = tid & 63, g = lane >> 3, cc = lane & 7; const int w = __builtin_amdgcn_readfirstlane(tid >> 6);
  const int* PE = (const int*)(lds + L_PE) + (w * 8 + g) * PEP; const int* PWQ = (const int*)(lds + L_PW) + (w * 8 + g) * PEP;
  const float deq = ((const float*)(lds + L_RS))[w * 8 + g];
  float* orow = out + ((size_t)tile * 64 + w * 8 + g) * 2048 + 16 * cc; const bf16_t* xrow = (const bf16_t*)(ws + WS_XB) + ((size_t)tile * 64 + w * 8 + g) * 2048 + 16 * cc;
  float ss = 0.f;
#define DN_LOAD(jb, B) do { _Pragma("unroll") for (int i_ = 0; i_ < 16; ++i_) { const unsigned e_ = (unsigned)PE[16 * (jb) + i_]; B[i_] = *(const u32x4*)(Vs + ((e_ << 7) + lo16)); } } while (0)
#define TQ(c_, d0_, d1_, d2_, d3_) do { const unsigned p_ = __builtin_amdgcn_perm(d1_, d0_, 0x05010400u), q_ = __builtin_amdgcn_perm(d1_, d0_, 0x07030602u), r_ = __builtin_amdgcn_perm(d3_, d2_, 0x05010400u), s_ = __builtin_amdgcn_perm(d3_, d2_, 0x07030602u); \
      ai[4 * (c_)] = __builtin_amdgcn_sdot4((int)__builtin_amdgcn_perm(r_, p_, 0x05040100u), wq_, ai[4 * (c_)], false); ai[4 * (c_) + 1] = __builtin_amdgcn_sdot4((int)__builtin_amdgcn_perm(r_, p_, 0x07060302u), wq_, ai[4 * (c_) + 1], false); \
      ai[4 * (c_) + 2] = __builtin_amdgcn_sdot4((int)__builtin_amdgcn_perm(s_, q_, 0x05040100u), wq_, ai[4 * (c_) + 2], false); ai[4 * (c_) + 3] = __builtin_amdgcn_sdot4((int)__builtin_amdgcn_perm(s_, q_, 0x07060302u), wq_, ai[4 * (c_) + 3], false); } while (0)
#define DN_COMP(jb, B) do { _Pragma("unroll") for (int u_ = 0; u_ < 4; ++u_) { const int wq_ = PWQ[4 * (jb) + u_]; const u32x4 e0_ = B[4 * u_], e1_ = B[4 * u_ + 1], e2_ = B[4 * u_ + 2], e3_ = B[4 * u_ + 3]; \
      TQ(0, e0_.x, e1_.x, e2_.x, e3_.x); TQ(1, e0_.y, e1_.y, e2_.y, e3_.y); TQ(2, e0_.z, e1_.z, e2_.z, e3_.z); TQ(3, e0_.w, e1_.w, e2_.w, e3_.w); } } while (0)
  const unsigned lo16 = 16u * (unsigned)cc;
#pragma unroll 1
  for (int sig = 0; sig < NSLICE; ++sig) {
    const unsigned char* Vs = ws + WS_UB + 32 * MiB + (size_t)sig * 16384 * 128;
    u32x4 bA[16], bB[16];
    DN_LOAD(0, bA); DN_LOAD(1, bB);
    float* p = orow + 128 * sig;
    const u32x4 ra = *(const u32x4*)(xrow + 128 * sig), rb = *(const u32x4*)(xrow + 128 * sig + 8);
    f32x4 x0 = {bflo(ra.x), bfhi(ra.x), bflo(ra.y), bfhi(ra.y)}, x1 = {bflo(ra.z), bfhi(ra.z), bflo(ra.w), bfhi(ra.w)}, x2 = {bflo(rb.x), bfhi(rb.x), bflo(rb.y), bfhi(rb.y)}, x3 = {bflo(rb.z), bfhi(rb.z), bflo(rb.w), bfhi(rb.w)};
    int ai[16];
#pragma unroll
    for (int k = 0; k < 16; ++k) ai[k] = 0;
#pragma unroll
    for (int jp = 0; jp < 4; ++jp) {
      __builtin_amdgcn_sched_barrier(0);
      DN_COMP(2 * jp, bA);
      __builtin_amdgcn_sched_barrier(0);
      if (jp < 3) DN_LOAD(2 * jp + 2, bA);
      __builtin_amdgcn_sched_barrier(0);
      DN_COMP(2 * jp + 1, bB);
      __builtin_amdgcn_sched_barrier(0);
      if (jp < 3) DN_LOAD(2 * jp + 3, bB);
      __builtin_amdgcn_sched_barrier(0); }
#pragma unroll
    for (int k = 0; k < 4; ++k) { x0[k] = fmaf((float)ai[k], deq, x0[k]); x1[k] = fmaf((float)ai[4 + k], deq, x1[k]); x2[k] = fmaf((float)ai[8 + k], deq, x2[k]); x3[k] = fmaf((float)ai[12 + k], deq, x3[k]); }
    *(f32x4*)p = x0; *(f32x4*)(p + 4) = x1; *(f32x4*)(p + 8) = x2; *(f32x4*)(p + 12) = x3;
    ss += ((x0[0] * x0[0] + x0[1] * x0[1]) + (x0[2] * x0[2] + x0[3] * x0[3])) + ((x1[0] * x1[0] + x1[1] * x1[1]) + (x1[2] * x1[2] + x1[3] * x1[3]))
        + ((x2[0] * x2[0] + x2[1] * x2[1]) + (x2[2] * x2[2] + x2[3] * x2[3])) + ((x3[0] * x3[0] + x3[1] * x3[1]) + (x3[2] * x3[2] + x3[3] * x3[3]));
  }
#undef DN_LOAD
#undef DN_COMP
#undef TQ
  ss += att::qx1(ss); ss += att::qx2(ss); ss += att::qm8(ss);
  const float rsl = rsqrtf(ss * (1.f / 2048.f) + EPS);
  float rsv[8];
#pragma unroll
  for (int tt = 0; tt < 8; ++tt) rsv[tt] = __shfl(rsl, tt * 8);
  asm volatile("s_waitcnt vmcnt(0)" ::: "memory");
  __builtin_amdgcn_fence(__ATOMIC_ACQUIRE, "agent");
  asm volatile("s_waitcnt vmcnt(0)" ::: "memory");
  float* obase = out + ((size_t)tile * 64 + w * 8) * 2048 + 4 * lane;
#pragma unroll
  for (int tt = 0; tt < 8; ++tt) {
#pragma unroll
    for (int q = 0; q < 8; ++q) { float* pp = obase + (size_t)tt * 2048 + 256 * q; const f32x4 x = *(const f32x4*)pp, f = *(const f32x4*)(fg + 4 * lane + 256 * q);
      f32x4 o; o[0] = x[0] * rsv[tt] * f[0]; o[1] = x[1] * rsv[tt] * f[1]; o[2] = x[2] * rsv[tt] * f[2]; o[3] = x[3] * rsv[tt] * f[3]; *(f32x4*)pp = o; }
    __builtin_amdgcn_sched_barrier(0); }
}
#undef FP8LO
#undef FP8HI
}


namespace gla {
using bf16x8 = __attribute__((ext_vector_type(8))) short;
using s16x4  = __attribute__((ext_vector_type(4))) short;
using f32x4  = __attribute__((ext_vector_type(4))) float;
constexpr int P_QK = 136, P_T = 72, P_LA = 129;
constexpr int L_QB = 0, L_KB = L_QB + 64 * P_QK * 2, L_KLT = L_KB + 64 * P_QK * 2, L_VT = L_KLT + 128 * P_T * 2, L_ATT = L_VT + 256 * P_T * 2, L_LA = L_ATT + 64 * P_T * 2, L_END = L_LA + 64 * P_LA * 4;
static_assert(L_END <= 147456 - 1024, "GLA LDS map");
constexpr size_t WS_ADEC = WS_SMALL + 512 * 1024;
__device__ __forceinline__ void passA(unsigned char* ws, char* lds, const float* __restrict__ wdecay, const float* __restrict__ bdecay, const int bh, const int c) {
  int tid_ = threadIdx.x; asm volatile("" : "+v"(tid_));
  const int tid = tid_, lane = tid & 63; const int cg = __builtin_amdgcn_readfirstlane(tid >> 6);
  const int b = bh >> 2, h = bh & 3; const int srow = lane; const size_t tok = (size_t)b * SEQ + 64 * c + srow;
  bf16_t* QB = (bf16_t*)(lds + L_QB); bf16_t* KB = (bf16_t*)(lds + L_KB); bf16_t* KLT = (bf16_t*)(lds + L_KLT); bf16_t* VT = (bf16_t*)(lds + L_VT); bf16_t* ATT = (bf16_t*)(lds + L_ATT); float* LA = (float*)(lds + L_LA);
  bf16_t* GQK = (bf16_t*)(ws + WS_GQK); bf16_t* GV = (bf16_t*)(ws + WS_GV);
  bf16x8 q8s[2], k8s[2], v8s[4];
#pragma unroll
  for (int i2 = 0; i2 < 2; ++i2) { const int ch = 2 * cg + i2; q8s[i2] = *(const bf16x8*)(GQK + tok * 1024 + h * 128 + 8 * ch); k8s[i2] = *(const bf16x8*)(GQK + tok * 1024 + 512 + h * 128 + 8 * ch); }
#pragma unroll
  for (int i4 = 0; i4 < 4; ++i4) v8s[i4] = *(const bf16x8*)(GV + tok * 1024 + h * 256 + 8 * (4 * cg + i4));
  float bc[16], bl[16];
  { float* GLs = (float*)(lds + L_LA); const int row = tid >> 3, u4 = tid & 3, sp2 = (tid >> 2) & 1; constexpr size_t SLAB = (size_t)T * 64;
    const float* sp0 = (const float*)(ws + WS_SMB) + ((size_t)b * SEQ + 64 * c + row) * 64 + 48 + 4 * u4 + (size_t)(2 * sp2) * SLAB;
    *(f32x4*)(GLs + row * 36 + sp2 * 16 + 4 * u4) = *(const f32x4*)sp0 + *(const f32x4*)(sp0 + SLAB); }
  const f32x4 wq = *(const f32x4*)(wdecay + (lane >> 2) * 512 + h * 128 + cg * 16 + 4 * (lane & 3));
  const float bq = bdecay[h * 128 + cg * 16 + (lane & 15)];
  __syncthreads();
#define RLF(x, l) __int_as_float(__builtin_amdgcn_readlane(__float_as_int(x), (l)))
  { float gl[16];
#pragma unroll
    for (int u = 0; u < 4; ++u) { const float* gp = (const float*)(lds + L_LA) + srow * 36 + 4 * u; const f32x4 v = *(const f32x4*)gp + *(const f32x4*)(gp + 16);
      gl[4 * u] = v[0]; gl[4 * u + 1] = v[1]; gl[4 * u + 2] = v[2]; gl[4 * u + 3] = v[3]; }
#pragma unroll
    for (int dd = 0; dd < 16; ++dd) { float z = RLF(bq, dd);
#pragma unroll
      for (int rr = 0; rr < 16; ++rr) z = fmaf(gl[rr], RLF(wq[dd & 3], rr * 4 + (dd >> 2)), z);
      const float ls = fminf(z, 0.f) - __logf(1.f + __expf(-fabsf(z)));
      float x = ls * (1.f / 16.f);
#define DPPF(v, ctrl, rmask, bc) __int_as_float(__builtin_amdgcn_update_dpp(0, __float_as_int(v), (ctrl), (rmask), 0xF, (bc)))
      x += DPPF(x, 0x111, 0xF, true); x += DPPF(x, 0x112, 0xF, true); x += DPPF(x, 0x114, 0xF, true); x += DPPF(x, 0x118, 0xF, true);
      x += DPPF(x, 0x142, 0xA, false); x += DPPF(x, 0x143, 0xC, false);
#undef DPPF
      bc[dd] = x; bl[dd] = RLF(x, 63); } }
#undef RLF
#pragma unroll
  for (int i2 = 0; i2 < 2; ++i2) { const int ch = 2 * cg + i2;
    bf16x8 q8 = q8s[i2]; const bf16x8 k8 = k8s[i2]; bf16x8 kb8;
#pragma unroll
    for (int e = 0; e < 8; ++e) { const int d = 8 * ch + e; const float bcv = bc[8 * i2 + e], blv = bl[8 * i2 + e]; const float kf = bf2f((bf16_t)k8[e]);
      q8[e] = (short)f2bf(bf2f((bf16_t)q8[e]) * 0.08838834764831845f * __expf(bcv)); kb8[e] = (short)f2bf(kf * __expf(-bcv)); KLT[d * P_T + srow] = f2bf(kf * __expf(blv - bcv));
 }
    *(bf16x8*)(QB + srow * P_QK + 8 * ch) = q8; *(bf16x8*)(KB + srow * P_QK + 8 * ch) = kb8; *(bf16x8*)(GQK + tok * 1024 + h * 128 + 8 * ch) = q8; }
  if (srow == 63) { float* ad = (float*)(ws + WS_ADEC) + ((size_t)bh * 64 + c) * 128 + 16 * cg;
#pragma unroll
    for (int u = 0; u < 4; ++u) *(f32x4*)(ad + 4 * u) = (f32x4){__expf(bl[4 * u]), __expf(bl[4 * u + 1]), __expf(bl[4 * u + 2]), __expf(bl[4 * u + 3])}; }
#pragma unroll
  for (int i4 = 0; i4 < 4; ++i4) { const int ch = 4 * cg + i4; const bf16x8 v8 = v8s[i4];
#pragma unroll
    for (int e = 0; e < 8; ++e) VT[(8 * ch + e) * P_T + srow] = (bf16_t)v8[e]; }
  __syncthreads();
  const int w = cg, i = lane & 15, gq = lane >> 4;
#pragma unroll
  for (int i2 = 0; i2 < 2; ++i2) { const int rt = w >> 1, ct = (w & 1) * 2 + i2; f32x4 acc = {0.f, 0.f, 0.f, 0.f};
#pragma unroll
    for (int ks = 0; ks < 4; ++ks) { const bf16x8 av = *(const bf16x8*)(QB + (16 * rt + i) * P_QK + 32 * ks + 8 * gq); const bf16x8 bv = *(const bf16x8*)(KB + (16 * ct + i) * P_QK + 32 * ks + 8 * gq);
      acc = __builtin_amdgcn_mfma_f32_16x16x32_bf16(av, bv, acc, 0, 0, 0); }
#pragma unroll
    for (int r = 0; r < 4; ++r) { const int t = 16 * rt + 4 * gq + r, s2 = 16 * ct + i; ATT[t * P_T + s2] = f2bf(s2 <= t ? acc[r] : 0.f); } }
  __syncthreads();
  { f32x4 acc[4][2];
#pragma unroll
    for (int rt = 0; rt < 4; ++rt) { acc[rt][0] = (f32x4){0.f, 0.f, 0.f, 0.f}; acc[rt][1] = (f32x4){0.f, 0.f, 0.f, 0.f}; }
#pragma unroll
    for (int ks = 0; ks < 2; ++ks) { bf16x8 bv[2];
#pragma unroll
      for (int ct = 0; ct < 2; ++ct) bv[ct] = *(const bf16x8*)(VT + (32 * w + 16 * ct + i) * P_T + 32 * ks + 8 * gq);
#pragma unroll
      for (int rt = 0; rt < 4; ++rt) { const bf16x8 av = *(const bf16x8*)(ATT + (16 * rt + i) * P_T + 32 * ks + 8 * gq);
        acc[rt][0] = __builtin_amdgcn_mfma_f32_16x16x32_bf16(av, bv[0], acc[rt][0], 0, 0, 0); acc[rt][1] = __builtin_amdgcn_mfma_f32_16x16x32_bf16(av, bv[1], acc[rt][1], 0, 0, 0); } }
    bf16_t* OT = (bf16_t*)(lds + L_QB); constexpr int PO = 264;
#pragma unroll
    for (int rt = 0; rt < 4; ++rt)
#pragma unroll
      for (int ct = 0; ct < 2; ++ct)
#pragma unroll
        for (int r = 0; r < 4; ++r) OT[(16 * rt + 4 * gq + r) * PO + 32 * w + 16 * ct + i] = f2bf(acc[rt][ct][r]); }
  __syncthreads();
  { const size_t tok0 = (size_t)b * SEQ + 64 * c; const bf16_t* OT = (const bf16_t*)(lds + L_QB); constexpr int PO = 264;
#pragma unroll
    for (int k = 0; k < 4; ++k) { const int id = tid + 512 * k, row = id >> 5, ch = id & 31; *(bf16x8*)(GV + (tok0 + row) * 1024 + h * 256 + 8 * ch) = *(const bf16x8*)(OT + row * PO + 8 * ch); } }
  { bf16_t* ST = (bf16_t*)(ws + WS_ST) + ((size_t)bh * 64 + c) * 256 * 128;
#pragma unroll
    for (int half = 0; half < 2; ++half) { f32x4 acc[4][2];
#pragma unroll
      for (int dt = 0; dt < 4; ++dt) { acc[dt][0] = (f32x4){0.f, 0.f, 0.f, 0.f}; acc[dt][1] = (f32x4){0.f, 0.f, 0.f, 0.f}; }
#pragma unroll
      for (int ks = 0; ks < 2; ++ks) { bf16x8 bv[2];
#pragma unroll
        for (int ct = 0; ct < 2; ++ct) bv[ct] = *(const bf16x8*)(VT + (32 * w + 16 * ct + i) * P_T + 32 * ks + 8 * gq);
#pragma unroll
        for (int dt = 0; dt < 4; ++dt) { const bf16x8 av = *(const bf16x8*)(KLT + (64 * half + 16 * dt + i) * P_T + 32 * ks + 8 * gq);
          acc[dt][0] = __builtin_amdgcn_mfma_f32_16x16x32_bf16(av, bv[0], acc[dt][0], 0, 0, 0); acc[dt][1] = __builtin_amdgcn_mfma_f32_16x16x32_bf16(av, bv[1], acc[dt][1], 0, 0, 0); } }
      bf16_t* MT = (bf16_t*)(lds + L_LA) + w * (32 * 72);
#pragma unroll
      for (int dt = 0; dt < 4; ++dt)
#pragma unroll
        for (int ct = 0; ct < 2; ++ct) { const int el = 16 * ct + i, d0 = 16 * dt + 4 * gq; const f32x4 v = acc[dt][ct];
          const unsigned lo = (unsigned)f2bf(v[0]) | ((unsigned)f2bf(v[1]) << 16), hi2 = (unsigned)f2bf(v[2]) | ((unsigned)f2bf(v[3]) << 16);
          *(unsigned long long*)(MT + el * 72 + d0) = (unsigned long long)lo | ((unsigned long long)hi2 << 32); }
      asm volatile("s_waitcnt lgkmcnt(0)" ::: "memory");
#pragma unroll
      for (int k = 0; k < 4; ++k) { const int id = lane + 64 * k, el = id >> 3, ch = id & 7;
        *(bf16x8*)(ST + (size_t)(32 * w + el) * 128 + 64 * half + 8 * ch) = *(const bf16x8*)(MT + el * 72 + 8 * ch); }
      asm volatile("s_waitcnt lgkmcnt(0)" ::: "memory"); } }
  __syncthreads();
}
__device__ __forceinline__ void scan(unsigned char* ws, const int bx, const int G) {
  typedef unsigned u32x2 __attribute__((ext_vector_type(2)));
  const int tid = threadIdx.x;
  for (int item = bx * 512 + tid; item < 16 * 256 * 32; item += G * 512) { const int bh = item >> 13, e = (item >> 5) & 255, dq = item & 31;
    float s0 = 0.f, s1 = 0.f, s2 = 0.f, s3 = 0.f;
    bf16_t* p = (bf16_t*)(ws + WS_ST) + ((size_t)bh * 64 * 256 + e) * 128 + 4 * dq; const float* ad = (const float*)(ws + WS_ADEC) + (size_t)bh * 64 * 128 + 4 * dq;
#pragma unroll 32
    for (int c = 0; c < 64; ++c) { const u32x2 m = *(const u32x2*)(p + (size_t)c * 256 * 128); const f32x4 a4 = *(const f32x4*)(ad + c * 128);
      u32x2 o; o.x = (unsigned)f2bf(s0) | ((unsigned)f2bf(s1) << 16); o.y = (unsigned)f2bf(s2) | ((unsigned)f2bf(s3) << 16); *(u32x2*)(p + (size_t)c * 256 * 128) = o;
      s0 = fmaf(a4[0], s0, __uint_as_float(m.x << 16)); s1 = fmaf(a4[1], s1, __uint_as_float(m.x & 0xffff0000u)); s2 = fmaf(a4[2], s2, __uint_as_float(m.y << 16)); s3 = fmaf(a4[3], s3, __uint_as_float(m.y & 0xffff0000u)); } }
}
__device__ __forceinline__ void passC(unsigned char* ws, unsigned char* Y8, char* lds, const float* __restrict__ gnorm, const int bh, const int c) {
  int tid_ = threadIdx.x; asm volatile("" : "+v"(tid_));
  const int tid = tid_, lane = tid & 63, i = lane & 15, gq = lane >> 4; const int w = __builtin_amdgcn_readfirstlane(tid >> 6);
  const int b = bh >> 2, h = bh & 3; const size_t tok0 = (size_t)b * SEQ + 64 * c;
  const bf16_t* GQK = (const bf16_t*)(ws + WS_GQK); bf16_t* GV = (bf16_t*)(ws + WS_GV); const bf16_t* GR = (const bf16_t*)(ws + WS_GR);
  const bf16_t* ST = (const bf16_t*)(ws + WS_ST) + ((size_t)bh * 64 + c) * 256 * 128;
  constexpr int PT = 264;
  bf16_t* OI = (bf16_t*)lds; bf16_t* GRT = (bf16_t*)(lds + 64 * PT * 2); float* red = (float*)(lds + 2 * 64 * PT * 2);
  bf16x8 oi[4], gr[4];
#pragma unroll
  for (int k = 0; k < 4; ++k) { const int id = tid + 512 * k, row = id >> 5, ch = id & 31; const size_t off = (tok0 + row) * 1024 + h * 256 + 8 * ch;
    oi[k] = *(const bf16x8*)(GV + off); gr[k] = *(const bf16x8*)(GR + off); }
  f32x4 acc[4][2];
#pragma unroll
  for (int rt = 0; rt < 4; ++rt) { acc[rt][0] = (f32x4){0.f, 0.f, 0.f, 0.f}; acc[rt][1] = (f32x4){0.f, 0.f, 0.f, 0.f}; }
#pragma unroll
  for (int ks = 0; ks < 4; ++ks) { bf16x8 bv[2];
#pragma unroll
    for (int ct = 0; ct < 2; ++ct) bv[ct] = *(const bf16x8*)(ST + (size_t)(32 * w + 16 * ct + i) * 128 + 32 * ks + 8 * gq);
#pragma unroll
    for (int rt = 0; rt < 4; ++rt) { const bf16x8 av = *(const bf16x8*)(GQK + (tok0 + 16 * rt + i) * 1024 + h * 128 + 32 * ks + 8 * gq);
      acc[rt][0] = __builtin_amdgcn_mfma_f32_16x16x32_bf16(av, bv[0], acc[rt][0], 0, 0, 0); acc[rt][1] = __builtin_amdgcn_mfma_f32_16x16x32_bf16(av, bv[1], acc[rt][1], 0, 0, 0); } }
#pragma unroll
  for (int k = 0; k < 4; ++k) { const int id = tid + 512 * k, row = id >> 5, ch = id & 31; *(bf16x8*)(OI + row * PT + 8 * ch) = oi[k]; *(bf16x8*)(GRT + row * PT + 8 * ch) = gr[k]; }
  __syncthreads();
#pragma unroll
  for (int rt = 0; rt < 4; ++rt)
#pragma unroll
    for (int r = 0; r < 4; ++r) { const int t = 16 * rt + 4 * gq + r; float ss = 0.f;
#pragma unroll
      for (int ct = 0; ct < 2; ++ct) { const float o = acc[rt][ct][r] + bf2f(OI[t * PT + 32 * w + 16 * ct + i]); acc[rt][ct][r] = o; ss += o * o; }
      ss += att::qx1(ss); ss += att::qx2(ss); ss += att::qm8(ss); ss += att::qm16(ss);
      if (i == 0) red[t * 8 + w] = ss; }
  __syncthreads();
#pragma unroll
  for (int rt = 0; rt < 4; ++rt)
#pragma unroll
    for (int r = 0; r < 4; ++r) { const int t = 16 * rt + 4 * gq + r; const f32x4 ra = *(const f32x4*)(red + t * 8), rb = *(const f32x4*)(red + t * 8 + 4);
      const float rs = rsqrtf(((ra[0] + ra[1]) + (ra[2] + ra[3]) + (rb[0] + rb[1]) + (rb[2] + rb[3])) * (1.f / 256.f) + EPS);
#pragma unroll
      for (int ct = 0; ct < 2; ++ct) { const int e = 32 * w + 16 * ct + i; const float rr = bf2f(GRT[t * PT + e]);
        OI[t * PT + e] = f2bf(acc[rt][ct][r] * rs * gnorm[e] * (rr * att::sigm(rr))); } }
  __syncthreads();
#pragma unroll
  for (int k = 0; k < 4; ++k) { const int id = tid + 512 * k, row = id >> 5, ch = id & 31; *(unsigned long long*)(Y8 + (tok0 + row) * 3072 + h * 256 + 8 * ch) = pg8::bf8_to_f8(*(const pg8::bf16x8*)(OI + row * PT + 8 * ch), 8.f); }
  __syncthreads();
}
}

namespace cg = cooperative_groups;
#define LAS __attribute__((address_space(3)))
typedef unsigned v4u __attribute__((ext_vector_type(4)));
typedef float f32x4 __attribute__((ext_vector_type(4)));
constexpr int NWAVES = 8, NTHREADS = 512, LDS_BYTES = 147456;
#define LDS_WAIT() asm volatile("s_waitcnt lgkmcnt(0)" ::: "memory")
__device__ __forceinline__ unsigned pk2(float lo, float hi) { typedef __bf16 bf2_t __attribute__((ext_vector_type(2))); const bf2_t v = {(__bf16)lo, (__bf16)hi}; return __builtin_bit_cast(unsigned, v); }


#define XB_TMO      128
#define XB_XCNT(j)  (256  + 64 * (j))
#define XB_XSUB(j)  (1280 + 64 * (j))
#define XB_XGEN(j)  (2304 + 64 * (j))
#define XB_TOP      3328
#define XB_TOPGEN   3392
#define XCD_BAR_WORDS 3456
#define XB_SPIN_CAP (1u << 18)

__device__ __forceinline__ unsigned xb_ld(unsigned* p)              { return __hip_atomic_load(p, __ATOMIC_RELAXED, __HIP_MEMORY_SCOPE_AGENT); }
__device__ __forceinline__ unsigned xb_add(unsigned* p, unsigned v) { return __hip_atomic_fetch_add(p, v, __ATOMIC_RELAXED, __HIP_MEMORY_SCOPE_AGENT); }
__device__ __forceinline__ unsigned xb_xcc_id() { return (unsigned)__builtin_amdgcn_s_getreg((3 << 11) | 20) & 0xFu; }
#define XB_SPIN(cond, bar) do { unsigned _sp = 0; while (cond) { __builtin_amdgcn_s_sleep(1); \
    if ((++_sp & 255u) == 0u) { if (xb_ld(&(bar)[XB_TMO])) break; if (_sp > XB_SPIN_CAP) { atomicAdd(&(bar)[XB_TMO], 1u); break; } } } } while (0)

struct XcdBarrier {
    unsigned* bar; unsigned x;
    volatile LAS unsigned* st;
};

__device__ __forceinline__ XcdBarrier xcd_barrier_post(unsigned* bar, volatile LAS unsigned* st) {
    XcdBarrier b; b.bar = bar; b.x = xb_xcc_id(); b.st = st;
    if (threadIdx.x == 0) (void)xb_add(&bar[XB_XCNT(b.x)], 1u);
    return b;
}
__device__ __forceinline__ void xcd_barrier_complete(unsigned* bar, unsigned x, unsigned& nloc, unsigned& nx) {
    const unsigned G = gridDim.x * gridDim.y * gridDim.z;
    unsigned sum, cnt, mine, sp = 0u;
    for (;;) {
        sum = 0u; cnt = 0u; mine = 0u;
#pragma unroll
        for (unsigned j = 0; j < 16; ++j) { const unsigned c = xb_ld(&bar[XB_XCNT(j)]); sum += c; cnt += (c > 0u) ? 1u : 0u; mine = (j == x) ? c : mine; }
        if (sum == G) break;
        __builtin_amdgcn_s_sleep(1);
        if ((++sp & 255u) == 0u) { if (xb_ld(&bar[XB_TMO])) break; if (sp > XB_SPIN_CAP) { atomicAdd(&bar[XB_TMO], 1u); break; } }
    }
    nloc = mine > 0u ? mine : 1u; nx = cnt > 0u ? cnt : 1u;
}

__device__ __forceinline__ void xcd_barrier(const XcdBarrier& b) {
    asm volatile("s_waitcnt vmcnt(0)" ::: "memory");
    __syncthreads();
    if (threadIdx.x == 0) {
        unsigned* bar = b.bar;
        __builtin_amdgcn_s_waitcnt(0);
        unsigned nloc = b.st[0], nx = b.st[1];
        if (nloc == 0u) { xcd_barrier_complete(bar, b.x, nloc, nx); b.st[0] = nloc; b.st[1] = nx; }
        const unsigned old = xb_add(&bar[XB_XSUB(b.x)], 1u);
        const unsigned gen = old / nloc;
        if (old + 1u == (gen + 1u) * nloc) {
            __builtin_amdgcn_fence(__ATOMIC_RELEASE, "agent");
            asm volatile("s_waitcnt vmcnt(0)" ::: "memory");
            const unsigned og = xb_add(&bar[XB_TOP], 1u);
            const unsigned tg = og / nx;
            if (og + 1u == (tg + 1u) * nx) xb_add(&bar[XB_TOPGEN], 1u);
            else XB_SPIN(xb_ld(&bar[XB_TOPGEN]) == tg, bar);
            __builtin_amdgcn_fence(__ATOMIC_ACQUIRE, "agent");
            xb_add(&bar[XB_XGEN(b.x)], 1u);
            asm volatile("s_waitcnt vmcnt(0)" ::: "memory");
        } else {
            XB_SPIN(xb_ld(&bar[XB_XGEN(b.x)]) == gen, bar);
            __builtin_amdgcn_fence(__ATOMIC_ACQUIRE, "agent");
            asm volatile("s_waitcnt vmcnt(0)" ::: "memory");
        }
    }
    __syncthreads();
}

struct Args { const float* in[23]; float* out; unsigned char* ws; int ph_lo, ph_hi, skip, pad; };

struct TrItem { const float* W; bf16_t* WT; const float* sc; int K, N, nblk, mode, item; unsigned char* W8; int lo8, ld8; };
__device__ __forceinline__ void tr_load(const TrItem& t, f32x4 (&v)[8], int lane) {
    const int kb = t.item / t.nblk, nb = t.item % t.nblk, k0 = 64 * kb, n0 = 32 * nb;
    const int np = n0 + 4 * (lane & 7); const int sn = t.mode ? src_col(np) : np; const bool ok = (sn >= 0) && (sn < t.N);
#pragma unroll
    for (int i = 0; i < 8; ++i) { const int kk = 8 * i + (lane >> 3); v[i] = ok ? __builtin_nontemporal_load((const f32x4*)(t.W + (size_t)(k0 + kk) * t.N + sn)) : (f32x4){0.f, 0.f, 0.f, 0.f}; }
}
__device__ __forceinline__ void tr_store(const TrItem& t, const f32x4 (&v)[8], LAS float* scr, int lane) {
    const int kb = t.item / t.nblk, nb = t.item % t.nblk, k0 = 64 * kb, n0 = 32 * nb;
#pragma unroll
    for (int i = 0; i < 8; ++i) { const int kk = 8 * i + (lane >> 3); const float sv = t.sc ? t.sc[k0 + kk] : 1.f; LAS float* d = scr + kk * 33 + 4 * (lane & 7);
        d[0] = v[i][0] * sv; d[1] = v[i][1] * sv; d[2] = v[i][2] * sv; d[3] = v[i][3] * sv; }
    LDS_WAIT(); asm volatile("" ::: "memory");
    const int c = lane & 7;
    if (t.W8 != nullptr && n0 >= t.lo8 && n0 < t.lo8 + 4096) {
#pragma unroll
      for (int j = 0; j < 4; ++j) { const int n = (lane >> 3) + 8 * j; const LAS float* s = scr + (8 * c) * 33 + n;
        int p0 = __builtin_amdgcn_cvt_pk_fp8_f32(s[0 * 33] * 64.f, s[1 * 33] * 64.f, 0, false); p0 = __builtin_amdgcn_cvt_pk_fp8_f32(s[2 * 33] * 64.f, s[3 * 33] * 64.f, p0, true);
        int p1 = __builtin_amdgcn_cvt_pk_fp8_f32(s[4 * 33] * 64.f, s[5 * 33] * 64.f, 0, false); p1 = __builtin_amdgcn_cvt_pk_fp8_f32(s[6 * 33] * 64.f, s[7 * 33] * 64.f, p1, true);
        *(unsigned long long*)(t.W8 + (size_t)(n0 + n - t.lo8) * t.ld8 + k0 + 8 * c) = (unsigned long long)(unsigned)p0 | ((unsigned long long)(unsigned)p1 << 32); }
    } else {
#pragma unroll
      for (int j = 0; j < 4; ++j) { const int n = (lane >> 3) + 8 * j; const LAS float* s = scr + (8 * c) * 33 + n;
        v4u o; o.x = pk2(s[0 * 33], s[1 * 33]); o.y = pk2(s[2 * 33], s[3 * 33]); o.z = pk2(s[4 * 33], s[5 * 33]); o.w = pk2(s[6 * 33], s[7 * 33]);
        *(v4u*)(t.WT + (size_t)(n0 + n) * t.K + k0 + 8 * c) = o; }
    }
    LDS_WAIT(); asm volatile("" ::: "memory");
}
__device__ __forceinline__ void rms_row_store(const f32x4 (&v)[8], const float* __restrict__ g, bf16_t* orow, unsigned char* orow8, int lane) {
    const f32x4* gr = (const f32x4*)g + lane; float s = 0.f;
#pragma unroll
    for (int j = 0; j < 8; ++j) s += (v[j].x * v[j].x + v[j].y * v[j].y) + (v[j].z * v[j].z + v[j].w * v[j].w);
    s = wave_sum(s); const float r = rsqrtf(s * (1.f / DM) + EPS);
    unsigned long long* o8 = (unsigned long long*)orow + lane;
#pragma unroll
    for (int j = 0; j < 8; ++j) { const f32x4 gg = gr[64 * j]; const float h0 = v[j].x * r * gg.x, h1 = v[j].y * r * gg.y, h2 = v[j].z * r * gg.z, h3 = v[j].w * r * gg.w;
        o8[64 * j] = (unsigned long long)pk2(h0, h1) | ((unsigned long long)pk2(h2, h3) << 32);
        int p8 = __builtin_amdgcn_cvt_pk_fp8_f32(h0, h1, 0, false); p8 = __builtin_amdgcn_cvt_pk_fp8_f32(h2, h3, p8, true); ((int*)orow8)[lane + 64 * j] = p8; }
}

__global__ void __launch_bounds__(NTHREADS, 2) mega(Args a) {
    extern __shared__ __attribute__((aligned(16))) unsigned char lds[];
    const int tid = threadIdx.x, lane = tid & 63, wave = __builtin_amdgcn_readfirstlane(tid >> 6);
    const int G = gridDim.x; const int bx = blockIdx.x;
    unsigned char* ws = a.ws;
    const int lo = a.ph_lo, hi = a.ph_hi; const int skip = a.skip;
#define SK(b) ((skip >> (b)) & 1)
    volatile LAS unsigned* bst = (volatile LAS unsigned*)((LAS unsigned char*)lds + (LDS_BYTES - 64));
    if (tid < 2) bst[tid] = 0u;
    __syncthreads();
    XcdBarrier xbar = xcd_barrier_post((unsigned*)(ws + WS_CTL) + 1024, bst);
#define GRID_BAR() xcd_barrier(xbar)
#define IN(k) (lo <= (k) && (k) < hi)
#define BOTH(k) (IN(k) && IN((k) + 1))
    if (IN(0)) {        LAS float* scr = (LAS float*)((LAS unsigned char*)lds + wave * 16384);
        const int gw = bx * NWAVES + wave, NGW = G * NWAVES;
        const float* x = a.in[0]; const int* pos = (const int*)a.in[1];
        constexpr int I_WIN = (DM / 64) * (NP / 32), I_W1 = (4096 / 64) * (128 / 32), I_W2 = (128 / 64) * (128 / 32);
        constexpr int NITEMS = I_WIN + 2 * I_W1 + 2 * I_W2;
        auto mk0 = [&](int it) __attribute__((always_inline)) { TrItem t; int r = it;
            if (r < I_WIN) { t = TrItem{a.in[3], (bf16_t*)(ws + WS_WINT), nullptr, DM, IN_COLS, NP / 32, 1, r, (unsigned char*)a.out + 32 * MiB, 8192, DM}; return t; } r -= I_WIN;
            if (r < I_W1) { t = TrItem{a.in[9], (bf16_t*)(ws + WS_W1T), nullptr, 4096, 128, 4, 0, r, nullptr, 0, 0}; return t; } r -= I_W1;
            if (r < I_W1) { t = TrItem{a.in[11], (bf16_t*)(ws + WS_W1T + MiB), nullptr, 4096, 128, 4, 0, r, nullptr, 0, 0}; return t; } r -= I_W1;
            if (r < I_W2) { t = TrItem{a.in[10], (bf16_t*)(ws + WS_SMALL + 64 * 1024), nullptr, 128, 128, 4, 0, r, nullptr, 0, 0}; return t; } r -= I_W2;
            t = TrItem{a.in[12], (bf16_t*)(ws + WS_SMALL + 128 * 1024), nullptr, 128, 128, 4, 0, r, nullptr, 0, 0}; return t; };
        { f32x4 vn[8]; TrItem tn{}; if (gw < NITEMS) { tn = mk0(gw); tr_load(tn, vn, lane); }
          for (int it = gw; it < NITEMS; it += NGW) { f32x4 vc[8]; const TrItem tc = tn;
#pragma unroll
            for (int i = 0; i < 8; ++i) vc[i] = vn[i];
            if (it + NGW < NITEMS) { tn = mk0(it + NGW); tr_load(tn, vn, lane); }
            tr_store(tc, vc, scr, lane); } }
        { f32x4 vn[8];
          if (gw < T) { const f32x4* xr = (const f32x4*)(x + (size_t)gw * DM) + lane;
#pragma unroll
            for (int j = 0; j < 8; ++j) vn[j] = __builtin_nontemporal_load(xr + 64 * j); }
          for (int m = gw; m < T; m += NGW) { f32x4 vc[8];
#pragma unroll
            for (int j = 0; j < 8; ++j) vc[j] = vn[j];
            if (m + NGW < T) { const f32x4* xr = (const f32x4*)(x + (size_t)(m + NGW) * DM) + lane;
#pragma unroll
              for (int j = 0; j < 8; ++j) vn[j] = __builtin_nontemporal_load(xr + 64 * j); }
            rms_row_store(vc, a.in[2], (bf16_t*)(ws + WS_HB) + (size_t)m * DM, (unsigned char*)a.out + (size_t)m * DM, lane); } }
        for (int idx = bx * NTHREADS + tid; idx < T * 16; idx += G * NTHREADS) { const int t = idx >> 4, i = idx & 15;
            const float inv = powf(500000.0f, -((float)(2 * i) / 32.0f)); const float ang = (float)pos[t] * inv;
            float* tab = (float*)(ws + WS_ROPE) + (size_t)idx * 2; tab[0] = cosf(ang); tab[1] = sinf(ang); }
        for (int it = gw; it < 256; it += NGW) { const int which = it >> 7, j = it & 127; const float* pp = a.in[which ? 8 : 7]; const float* w1 = a.in[which ? 11 : 9];
            float s = 0.f; for (int k = lane; k < 4096; k += 64) s += pp[k] * w1[(size_t)k * 128 + j]; s = wave_sum(s);
            if (lane == 0) ((float*)(ws + WS_SMALL))[which * 128 + j] = s; }
        if (BOTH(0)) GRID_BAR();
    }
    if (IN(1)) {
        pg8::Gemm g{(const bf16_t*)(ws + WS_HB), (const bf16_t*)(ws + WS_WINT), T, 8192, DM, DM}; pg8::StaticOrder S; S.init(T, 8192, G, bx);
        pg8::EpiRoute E{ws};
        pg8::gemm_phase<pg8::EpiRoute, pg8::StaticOrder, true, true>((PG8_LAS unsigned char*)lds, g, S, E);
        { pg8::Gemm g8{(const bf16_t*)a.out, (const bf16_t*)((const unsigned char*)a.out + 32 * MiB), T, 4096, 1024, 1024}; pg8::StaticOrder S8; S8.init(T, 4096, G, bx);
          pg8::EpiGateLogits E8{(bf16_t*)(ws + WS_GAB), (bf16_t*)(ws + WS_GAB + 64 * MiB)};
          pg8::gemm_phase<pg8::EpiGateLogits, pg8::StaticOrder, true, true, true>((PG8_LAS unsigned char*)lds, g8, S8, E8); }
        { pg8::Gemm g2{(const bf16_t*)(ws + WS_HB), (const bf16_t*)(ws + WS_WINT) + (size_t)12288 * DM, T, 256, 512, DM}; pg8::SplitKOrder S2{G, bx}; pg8::EpiSlab E2{(float*)(ws + WS_SMB)};
          pg8::gemm_phase<pg8::EpiSlab, pg8::SplitKOrder, true, true>((PG8_LAS unsigned char*)lds, g2, S2, E2); }
        if (BOTH(1)) GRID_BAR();
    }
    if (IN(2)) {        LAS float* scr = (LAS float*)((LAS unsigned char*)lds + wave * 16384);
        const int gw = bx * NWAVES + wave, NGW = G * NWAVES;
        constexpr int I_G = (1024 / 64) * (DM / 32), I_N = (DM / 64) * (DM / 32), I_Q = (DM / 64) * (1024 / 32);
        constexpr int NITEMS = I_G + 2 * I_N + I_Q;
        auto mk2 = [&](int it) __attribute__((always_inline)) { TrItem t; int r = it;
            if (r < I_G) { t = TrItem{a.in[13], (bf16_t*)(ws + WS_WGT), nullptr, 1024, DM, DM / 32, 0, r, (unsigned char*)a.out + 96 * MiB, 0, 3072}; return t; } r -= I_G;
            if (r < I_N) { t = TrItem{a.in[14], (bf16_t*)(ws + WS_WNT), nullptr, DM, DM, DM / 32, 0, r, (unsigned char*)a.out + 96 * MiB + 1024, 0, 3072}; return t; } r -= I_N;
            if (r < I_N) { t = TrItem{a.in[15], (bf16_t*)(ws + WS_WOT), nullptr, DM, DM, DM / 32, 0, r, nullptr, 0, 0}; return t; } r -= I_N;
            t = TrItem{a.in[17], (bf16_t*)(ws + WS_WQT), a.in[16], DM, 1024, 1024 / 32, 0, r, nullptr, 0, 0}; return t; };
        { f32x4 vn[8]; TrItem tn{}; if (gw < NITEMS) { tn = mk2(gw); tr_load(tn, vn, lane); }
          for (int it = gw; it < NITEMS; it += NGW) { f32x4 vc[8]; const TrItem tc = tn;
#pragma unroll
            for (int i = 0; i < 8; ++i) vc[i] = vn[i];
            if (it + NGW < NITEMS) { tn = mk2(it + NGW); tr_load(tn, vn, lane); }
            tr_store(tc, vc, scr, lane); } }
        __syncthreads();
        if (!SK(4)) for (int u = bx; u < 256; u += G) cmpu::cmp_unit(ws, (char*)lds, u >> 7, (u >> 3) & 15, u & 7);
        if (!SK(5)) for (int u = bx; u < 1024; u += G) gla::passA(ws, (char*)lds, a.in[4], a.in[5], u >> 6, u & 63);
        if (BOTH(2)) GRID_BAR();
    }
    if (IN(3)) {
        gla::scan(ws, bx, G);
        if (BOTH(3)) GRID_BAR();
    }
    if (IN(4)) {        const int vcu = (G % 8 == 0) ? (bx % 8) * (G / 8) + bx / 8 : bx;
        if (!SK(0)) for (int u = vcu; u < 256; u += G) { const int bg = u >> 4, s_ = u & 15;
#pragma unroll 1
            for (int k = 0; k < 4; ++k) { const int c = (k == 0) ? 63 - s_ : (k == 1) ? 32 + s_ : (k == 2) ? 31 - s_ : s_;
                att::nsa_unit(ws, (unsigned char*)a.out + 48 * MiB, (char*)lds, bg >> 2, bg & 3, c, skip); } }
        if (!SK(1)) for (int u = bx; u < 1024; u += G) gla::passC(ws, (unsigned char*)a.out + 48 * MiB, (char*)lds, a.in[6], u >> 6, u & 63);
        if (BOTH(4)) GRID_BAR();
    }
    if (IN(5)) {
        if (!SK(13)) { pg8::Gemm g{(const bf16_t*)((const unsigned char*)a.out + 48 * MiB), (const bf16_t*)((const unsigned char*)a.out + 96 * MiB), T, DM, 1536, 1536}; pg8::StaticOrder S; S.init(T, DM, G, bx); pg8::EpiGateFused E{ws, 1.f / 512.f};
          pg8::gemm_phase<pg8::EpiGateFused, pg8::StaticOrder, true, true, true>((PG8_LAS unsigned char*)lds, g, S, E); }
        if (BOTH(5)) GRID_BAR();
    }
    if (IN(6)) {
        pg8::Gemm g{(const bf16_t*)(ws + WS_MERGED), (const bf16_t*)(ws + WS_WOT), T, DM, DM, DM}; pg8::StaticOrder S; S.init(T, DM, G, bx); pg8::EpiOut E{ws, a.in[0], a.out};
        pg8::gemm_phase<pg8::EpiOut, pg8::StaticOrder, true, true>((PG8_LAS unsigned char*)lds, g, S, E);
        if (BOTH(6)) GRID_BAR();
    }
    auto conv_tables = [&]() __attribute__((always_inline)) {
        { const int gw = bx * NWAVES + wave, NGW = G * NWAVES; float* SC = (float*)(ws + WS_UB + 64 * MiB);
          f32x4 nv[8];
          if (!SK(8) && gw < 2 * 16384) { const float* src = a.in[20 + (gw >> 14)] + (size_t)(gw & 16383) * 2048 + 4 * lane;
#pragma unroll
            for (int q = 0; q < 8; ++q) nv[q] = __builtin_nontemporal_load((const f32x4*)(src + 256 * q)); }
          if (!SK(8)) for (int r = gw; r < 2 * 16384; r += NGW) { const int tab = r >> 14, e = r & 16383;
            f32x4 v[8]; float am = 0.f;
#pragma unroll
            for (int q = 0; q < 8; ++q) { v[q] = nv[q]; am = fmaxf(am, fmaxf(fmaxf(fabsf(v[q].x), fabsf(v[q].y)), fmaxf(fabsf(v[q].z), fabsf(v[q].w)))); }
            const int rn = r + NGW;
            if (rn < 2 * 16384) { const float* src = a.in[20 + (rn >> 14)] + (size_t)(rn & 16383) * 2048 + 4 * lane;
#pragma unroll
              for (int q = 0; q < 8; ++q) nv[q] = __builtin_nontemporal_load((const f32x4*)(src + 256 * q)); }
            am = wave_max(am); const float sc = am > 0.f ? am * (1.f / 127.f) : 1.f; const float inv = 1.f / sc;
            unsigned char* dstb = ws + WS_UB + (size_t)tab * 32 * MiB + (size_t)e * 128 + 4 * (lane & 31);
#pragma unroll
            for (int q = 0; q < 8; ++q) { const int pk = (__float2int_rn(v[q].x * inv) & 255) | ((__float2int_rn(v[q].y * inv) & 255) << 8) | ((__float2int_rn(v[q].z * inv) & 255) << 16) | (__float2int_rn(v[q].w * inv) << 24);
              *(int*)(dstb + (size_t)(2 * q + (lane >> 5)) * 16384 * 128) = pk; }
            if (lane == 0) SC[r] = sc; } }
    };
    if (IN(7)) {
        pg8::Gemm g{(const bf16_t*)(ws + WS_XB), (const bf16_t*)(ws + WS_WQT), T, 1024, DM, DM}; pg8::StaticOrder S; S.init(T, 1024, G, bx);
        float* rs_tab = (float*)(lds + 132096);
        { pg8::Unit u0; if (S.next(0, u0) && tid < 256) { const float* sp = (const float*)(ws + WS_W1T) + (size_t)(u0.pm * 256 + tid) * 32; float sq = 0.f;
#pragma unroll
            for (int k = 0; k < 8; ++k) { const f32x4 v = *(const f32x4*)(sp + 4 * k); sq += (v[0] + v[1]) + (v[2] + v[3]); }
            rs_tab[tid] = rsqrtf(sq * (1.f / 2048.f) + EPS); }
          __syncthreads(); }
        pg8::EpiQP E{ws, rs_tab};
        pg8::gemm_phase<pg8::EpiQP, pg8::StaticOrder, true, true>((PG8_LAS unsigned char*)lds, g, S, E);
        if (BOTH(7)) GRID_BAR();
    }
    if (IN(8)) {
        if (G >= T / 64) {
            const int tile = bx;
            if (bx & 1) { if (tile < T / 64) { peer::route_tile(ws, (char*)lds, a.in[18], a.in[19], tile); __syncthreads(); } conv_tables(); }
            else { conv_tables(); if (tile < T / 64) { peer::route_tile(ws, (char*)lds, a.in[18], a.in[19], tile); __syncthreads(); } }
            GRID_BAR();
            if (tile < T / 64) {
                if (!SK(6)) peer::up_pass(ws, (char*)lds, a.in[16], tile);
                if (!SK(7)) peer::down_pass(ws, (char*)lds, a.out, a.in[22], tile);
                __syncthreads(); }
        } else {
            conv_tables(); GRID_BAR();
            for (int tile = bx; tile < T / 64; tile += G) {
                peer::route_tile(ws, (char*)lds, a.in[18], a.in[19], tile);
                __syncthreads();
                if (!SK(6)) peer::up_pass(ws, (char*)lds, a.in[16], tile);
                if (!SK(7)) peer::down_pass(ws, (char*)lds, a.out, a.in[22], tile);
                __syncthreads();
            }
        }
    }
#undef IN
#undef BOTH
}

static int g_grid = 0;
static void launch_mega(Args& a, int lo, int hi, hipStream_t stream, int skip = 0) {
  a.ph_lo = lo; a.ph_hi = hi; a.skip = skip; a.pad = 0; void* args[] = {&a};
  (void)hipMemsetAsync(a.ws + WS_CTL, 0, 65536, stream);
  hipError_t e = hipLaunchCooperativeKernel((const void*)mega, dim3(g_grid), dim3(NTHREADS), args, LDS_BYTES, stream);
  if (e != hipSuccess) fprintf(stderr, "cooperative launch failed: %s (grid %d)\n", hipGetErrorString(e), g_grid);
}
extern "C" void kernel_launch(void* const* d_in, const int* in_sizes, int n_in, void* d_out, int out_size, void* d_ws, size_t ws_size, hipStream_t stream) {
  if (n_in != 23 || in_sizes[0] != T * DM || out_size != T * DM || ws_size < WS_END) { fprintf(stderr, "kernel_launch: bad shapes/ws: n_in %d ws %zu need %zu\n", n_in, ws_size, (size_t)WS_END); return; }
  if (g_grid == 0) {
    int dev = 0, cus = 0, per_cu = 0;
    (void)hipGetDevice(&dev); (void)hipDeviceGetAttribute(&cus, hipDeviceAttributeMultiprocessorCount, dev);
    if (hipFuncSetAttribute((const void*)mega, hipFuncAttributeMaxDynamicSharedMemorySize, LDS_BYTES) != hipSuccess) fprintf(stderr, "hipFuncSetAttribute(mega) failed\n");
    if (hipOccupancyMaxActiveBlocksPerMultiprocessor(&per_cu, (const void*)mega, NTHREADS, LDS_BYTES) != hipSuccess || per_cu < 1) { fprintf(stderr, "occupancy query failed (%d)\n", per_cu); per_cu = 1; }
    (void)hipGetLastError();
    g_grid = cus * (per_cu > 1 ? 1 : per_cu);
    fprintf(stderr, "mega: cus %d per_cu %d grid %d ws %zu MiB\n", cus, per_cu, g_grid, ws_size >> 20);
  }
  unsigned char* ws = (unsigned char*)d_ws; float* out = (float*)d_out;
  Args a{}; for (int i = 0; i < 23; ++i) a.in[i] = (const float*)d_in[i]; a.out = out; a.ws = ws;
#ifdef PROBE_K
#ifndef PROBE_SKIP
#define PROBE_SKIP 0
#endif
  launch_mega(a, 0, PROBE_K + 1, stream, 0);
  launch_mega(a, 0, PROBE_K + 1, stream, PROBE_SKIP);
#endif
  launch_mega(a, 0, 9, stream);
}
```
